# Optimizing an MI355X kernel written in HIP

```python
import math
import jax, jax.numpy as jnp
from jax import lax
import numpy as np

D_MODEL = 1024
BATCH = 8
SEQ = 8192
DEPTH = 2

GRID_W = 64
CTX_LEN = 256
N_MIXERS = 2
N_HEADS = 16
N_KV_HEADS = 4
HEAD_DIM = D_MODEL // N_HEADS
GROUP = N_HEADS // N_KV_HEADS
WINDOW = 128
BLOCK = 128
ROPE_THETA = 10000.0
ROPE_HALF = HEAD_DIM // 2
AXIS_FREQS = ROPE_HALF // 2
ATTN_SCALE = HEAD_DIM ** -0.5
D_FF = ((-(-8 * D_MODEL // 3) + 255) // 256) * 256
HY_EMB = 33
HY_BANDS = (HY_EMB - 1) // 2
HY_HIDDEN = 64
HY_SHORT = 3
HY_DECAY_TARGET = 1e-2
HY_FAST_PCT = 0.3
HY_SLOW_PCT = 1.5
EPS = 1e-6
NEG = -1e30

kernel_name = "hybrid_swa_hyena_dit_block"


def rms_norm(x, g):
    xf = x.astype(jnp.float32)
    y = xf * lax.rsqrt(jnp.mean(xf * xf, axis=-1, keepdims=True) + EPS)
    return (y * g.astype(jnp.float32)).astype(x.dtype)


def modulate(h, shift, scale):
    return h * (1 + scale) + shift


def ada_chunks(cond, w, b):
    m = jax.nn.silu(cond) @ w + b
    return jnp.split(m[:, None, :], 6, axis=-1)


def axial_rope_tables(L):
    rows = L // GRID_W
    row = jnp.repeat(jnp.arange(rows, dtype=jnp.float32), GRID_W)
    col = jnp.tile(jnp.arange(GRID_W, dtype=jnp.float32), rows)
    inv_freq = ROPE_THETA ** (-jnp.arange(AXIS_FREQS, dtype=jnp.float32) / AXIS_FREQS)
    ang = jnp.concatenate([row[:, None] * inv_freq, col[:, None] * inv_freq], axis=-1)
    return jnp.cos(ang), jnp.sin(ang)


def apply_rope(x, cos, sin):
    c = cos[None, :, None, :].astype(x.dtype)
    s = sin[None, :, None, :].astype(x.dtype)
    x1, x2 = x[..., :ROPE_HALF], x[..., ROPE_HALF:]
    return jnp.concatenate([x1 * c - x2 * s, x1 * s + x2 * c], axis=-1)


def q_proj(h, wqkv, q_gain):
    B, L, _ = h.shape
    q = (h @ wqkv[:, :N_HEADS * HEAD_DIM]).reshape(B, L, N_HEADS, HEAD_DIM)
    return rms_norm(q, q_gain)


def kv_proj(h, wqkv, k_gain):
    B, L, _ = h.shape
    kv = h @ wqkv[:, N_HEADS * HEAD_DIM:]
    k = kv[..., :N_KV_HEADS * HEAD_DIM].reshape(B, L, N_KV_HEADS, HEAD_DIM)
    v = kv[..., N_KV_HEADS * HEAD_DIM:].reshape(B, L, N_KV_HEADS, HEAD_DIM)
    return rms_norm(k, k_gain), v


def sink_softmax(scores, values, sink):
    sink = sink.astype(jnp.float32).reshape(N_KV_HEADS, GROUP)[None, :, :, None, None]
    m = sink
    for s in scores:
        m = jnp.maximum(m, jnp.max(s, axis=-1, keepdims=True))
    denom = jnp.exp(sink - m)
    out = 0.0
    for s, v in zip(scores, values):
        p = jnp.exp(s - m)
        denom = denom + jnp.sum(p, axis=-1, keepdims=True)
        out = out + jnp.einsum('bkgts,bskd->bkgtd', p.astype(v.dtype), v).astype(jnp.float32)
    out = out / denom
    return out.transpose(0, 3, 1, 2, 4).astype(values[0].dtype)


def windowed_attention(q, k, v, kc, vc, sink):
    B, L, _, _ = q.shape
    nb = L // BLOCK
    qg = q.reshape(B, nb, BLOCK, N_KV_HEADS, GROUP, HEAD_DIM).transpose(1, 0, 2, 3, 4, 5)

    def band(t):
        tp = jnp.pad(t, ((0, 0), (BLOCK, BLOCK), (0, 0), (0, 0)))
        tp = tp.reshape(B, nb + 2, BLOCK, N_KV_HEADS, HEAD_DIM)
        tb = jnp.concatenate([tp[:, :nb], tp[:, 1:nb + 1], tp[:, 2:nb + 2]], axis=2)
        return tb.transpose(1, 0, 2, 3, 4)

    kb_all, vb_all = band(k), band(v)

    def block_fn(args):
        qb, kb, vb, b = args
        s_loc = jnp.einsum('btkgd,bskd->bkgts', qb, kb).astype(jnp.float32) * ATTN_SCALE
        qpos = b * BLOCK + jnp.arange(BLOCK)
        kpos = (b - 1) * BLOCK + jnp.arange(3 * BLOCK)
        valid = ((jnp.abs(qpos[:, None] - kpos[None, :]) <= WINDOW)
                 & (kpos[None, :] >= 0) & (kpos[None, :] < L))
        s_loc = jnp.where(valid, s_loc, NEG)
        s_ctx = jnp.einsum('btkgd,bckd->bkgtc', qb, kc).astype(jnp.float32) * ATTN_SCALE
        return sink_softmax([s_loc, s_ctx], [vb, vc], sink)

    o = lax.map(block_fn, (qg, kb_all, vb_all, jnp.arange(nb)))
    return o.transpose(1, 0, 2, 3, 4, 5).reshape(B, L, N_HEADS * HEAD_DIM)


def context_attention(qc, kc, vc, sink):
    B, Lc, _, _ = qc.shape
    qg = qc.reshape(B, Lc, N_KV_HEADS, GROUP, HEAD_DIM)
    s = jnp.einsum('bqkgd,bckd->bkgqc', qg, kc).astype(jnp.float32) * ATTN_SCALE
    return sink_softmax([s], [vc], sink).reshape(B, Lc, N_HEADS * HEAD_DIM)


def hyena_filter_fft(L, w1, b1, freq1, w2, b2, freq2, w_out, decay):
    f32 = jnp.float32
    t = jnp.linspace(0.0, 1.0, L, dtype=f32)[:, None]
    w = 2.0 * math.pi * jnp.arange(L, dtype=f32)[:, None] / L
    bands = jnp.linspace(1e-4, HY_BANDS - 1, HY_BANDS, dtype=f32)[None, :]
    z = jnp.concatenate([t, jnp.cos(bands * w), -jnp.sin(bands * w)], axis=-1)
    hdn = jnp.sin(freq1.astype(f32) * (z @ w1.astype(f32) + b1.astype(f32)))
    hdn = jnp.sin(freq2.astype(f32) * (hdn @ w2.astype(f32) + b2.astype(f32)))
    hh = hdn @ w_out.astype(f32)
    window = jnp.exp(-t * jnp.abs(decay.astype(f32))[None, :])
    h_fwd = hh[:, :D_MODEL] * window
    h_bwd = hh[:, D_MODEL:] * window
    k = jnp.concatenate([h_fwd, jnp.zeros((1, D_MODEL), f32), h_bwd[1:][::-1]], axis=0)
    k = k / jnp.sum(jnp.abs(k), axis=0, keepdims=True)
    return jnp.fft.rfft(k, n=2 * L, axis=0)


def hyena_mix(h, K, w_in, b_in, conv_w, conv_b, skip, w_out, b_out):
    B, L, _ = h.shape
    z = h @ w_in + b_in
    zp = jnp.pad(z, ((0, 0), (1, 1), (0, 0)))
    z = zp[:, :-2] * conv_w[0] + zp[:, 1:-1] * conv_w[1] + zp[:, 2:] * conv_w[2] + conv_b
    x0, x1, v = jnp.split(z, 3, axis=-1)
    u = (v * x1).astype(jnp.float32)
    U = jnp.fft.rfft(u, n=2 * L, axis=1)
    y = jnp.fft.irfft(U * K[None], n=2 * L, axis=1)[:, :L]
    y = (y + u * skip.astype(jnp.float32)).astype(h.dtype) * x0
    return y @ w_out + b_out


def swiglu(h, w1, w3, w2):
    return (jax.nn.silu(h @ w1) * (h @ w3)) @ w2


def setup_inputs(seed: int = 0) -> dict:
    key = jax.random.key(seed)
    ks = iter(jax.random.split(key, 48))
    f32 = jnp.float32

    def nrm(shape, scale):
        return scale * jax.random.normal(next(ks), shape, f32)

    D = D_MODEL
    NA = len(range(0, DEPTH, N_MIXERS))
    NB = len(range(1, DEPTH, N_MIXERS))
    qkv_w = (N_HEADS + 2 * N_KV_HEADS) * HEAD_DIM
    fast = -math.log(HY_DECAY_TARGET) / HY_FAST_PCT
    slow = -math.log(HY_DECAY_TARGET) / HY_SLOW_PCT
    decay_base = jnp.linspace(fast, slow, D, dtype=f32)[None, :]
    return {
        "x": nrm((BATCH, SEQ, D), 1.0),
        "c": nrm((BATCH, D), 1.0),
        "ctx": nrm((BATCH, CTX_LEN, D), 1.0),
        "c_ctx": nrm((D,), 1.0),
        "ada_w": nrm((DEPTH, D, 6 * D), 0.5 * D ** -0.5),
        "ada_b": nrm((DEPTH, 6 * D), 0.02),
        "norm1_g": 1.0 + nrm((DEPTH, D), 0.05),
        "norm2_g": 1.0 + nrm((DEPTH, D), 0.05),
        "attn_wqkv": nrm((NA, D, qkv_w), D ** -0.5),
        "attn_wo": nrm((NA, N_HEADS * HEAD_DIM, D), (N_HEADS * HEAD_DIM) ** -0.5),
        "attn_q_gain": 1.0 + nrm((NA, HEAD_DIM), 0.05),
        "attn_k_gain": 1.0 + nrm((NA, HEAD_DIM), 0.05),
        "attn_sink": nrm((NA, N_HEADS), 0.5),
        "hy_w_in": nrm((NB, D, 3 * D), D ** -0.5),
        "hy_b_in": nrm((NB, 3 * D), 0.02),
        "hy_conv_w": nrm((NB, HY_SHORT, 3 * D), HY_SHORT ** -0.5),
        "hy_conv_b": nrm((NB, 3 * D), 0.02),
        "hy_f_w1": nrm((NB, HY_EMB, HY_HIDDEN), HY_EMB ** -0.5),
        "hy_f_b1": nrm((NB, HY_HIDDEN), 0.5),
        "hy_f_freq1": 1.0 + nrm((NB, HY_HIDDEN), 0.1),
        "hy_f_w2": nrm((NB, HY_HIDDEN, HY_HIDDEN), HY_HIDDEN ** -0.5),
        "hy_f_b2": nrm((NB, HY_HIDDEN), 0.5),
        "hy_f_freq2": 1.0 + nrm((NB, HY_HIDDEN), 0.1),
        "hy_f_wout": nrm((NB, HY_HIDDEN, 2 * D), HY_HIDDEN ** -0.5),
        "hy_decay": decay_base * (1.0 + nrm((NB, D), 0.05)),
        "hy_skip": nrm((NB, D), 1.0),
        "hy_w_out": nrm((NB, D, D), D ** -0.5),
        "hy_b_out": nrm((NB, D), 0.02),
        "ffn_w1": nrm((DEPTH, D, D_FF), D ** -0.5),
        "ffn_w3": nrm((DEPTH, D, D_FF), D ** -0.5),
        "ffn_w2": nrm((DEPTH, D_FF, D), D_FF ** -0.5),
    }


def reference(x, c, ctx, c_ctx, ada_w, ada_b, norm1_g, norm2_g,
              attn_wqkv, attn_wo, attn_q_gain, attn_k_gain, attn_sink,
              hy_w_in, hy_b_in, hy_conv_w, hy_conv_b,
              hy_f_w1, hy_f_b1, hy_f_freq1, hy_f_w2, hy_f_b2, hy_f_freq2, hy_f_wout,
              hy_decay, hy_skip, hy_w_out, hy_b_out,
              ffn_w1, ffn_w3, ffn_w2):
    L = x.shape[1]
    Lc = ctx.shape[1]
    cos, sin = axial_rope_tables(L)
    last_ctx_reader = ((DEPTH - 1) // N_MIXERS) * N_MIXERS
    xc = ctx
    for i in range(DEPTH):
        upd = i < last_ctx_reader
        sh1, sc1, g1, sh2, sc2, g2 = ada_chunks(c, ada_w[i], ada_b[i])
        csh1, csc1, cg1, csh2, csc2, cg2 = ada_chunks(c_ctx[None, :], ada_w[i], ada_b[i])
        h = modulate(rms_norm(x, norm1_g[i]), sh1, sc1)
        if i % N_MIXERS == 0:
            a = i // N_MIXERS
            hc = modulate(rms_norm(xc, norm1_g[i]), csh1, csc1)
            kc, vc = kv_proj(hc, attn_wqkv[a], attn_k_gain[a])
            q = apply_rope(q_proj(h, attn_wqkv[a], attn_q_gain[a]), cos, sin)
            k, v = kv_proj(h, attn_wqkv[a], attn_k_gain[a])
            k = apply_rope(k, cos, sin)
            o = windowed_attention(q, k, v, kc, vc, attn_sink[a])
            x = x + g1 * (o @ attn_wo[a])
            if upd:
                qc = q_proj(hc, attn_wqkv[a], attn_q_gain[a])
                oc = context_attention(qc, kc, vc, attn_sink[a])
                xc = xc + cg1 * (oc @ attn_wo[a])
        else:
            j = i // N_MIXERS
            K = hyena_filter_fft(L, hy_f_w1[j], hy_f_b1[j], hy_f_freq1[j], hy_f_w2[j],
                                 hy_f_b2[j], hy_f_freq2[j], hy_f_wout[j], hy_decay[j])
            x = x + g1 * hyena_mix(h, K, hy_w_in[j], hy_b_in[j], hy_conv_w[j], hy_conv_b[j],
                                   hy_skip[j], hy_w_out[j], hy_b_out[j])
            if upd:
                hc = modulate(rms_norm(xc, norm1_g[i]), csh1, csc1)
                Kc = hyena_filter_fft(Lc, hy_f_w1[j], hy_f_b1[j], hy_f_freq1[j], hy_f_w2[j],
                                      hy_f_b2[j], hy_f_freq2[j], hy_f_wout[j], hy_decay[j])
                xc = xc + cg1 * hyena_mix(hc, Kc, hy_w_in[j], hy_b_in[j], hy_conv_w[j],
                                          hy_conv_b[j], hy_skip[j], hy_w_out[j], hy_b_out[j])
        x = x + g2 * swiglu(modulate(rms_norm(x, norm2_g[i]), sh2, sc2),
                            ffn_w1[i], ffn_w3[i], ffn_w2[i])
        if upd:
            xc = xc + cg2 * swiglu(modulate(rms_norm(xc, norm2_g[i]), csh2, csc2),
                                   ffn_w1[i], ffn_w3[i], ffn_w2[i])
    return x
```

```cpp
#include <hip/hip_runtime.h>
#include <hip/hip_cooperative_groups.h>
#include <cstdio>
#include <cstdint>
#include <cmath>
namespace cg = cooperative_groups;
namespace pg8 {
#define PG8_LAS __attribute__((address_space(3)))
typedef unsigned short bf16_t;
typedef short bf16x8 __attribute__((ext_vector_type(8)));
typedef float f32x4 __attribute__((ext_vector_type(4)));
typedef unsigned u32x4 __attribute__((ext_vector_type(4)));
constexpr int BM = 256, BK = 64, HALF = 128, HTB = HALF * BK * 2  , STAGE_BYTES = 8 * HTB, NXCD = 8, WGM = 8;

__host__ __device__ __forceinline__ int lds_byte(int r, int c) { const int st = (r >> 4) * 2 + (c >> 5), rr = r & 15, cc = c & 31, ob = rr * 64 + cc * 2; return st * 1024 + (ob ^ (((ob >> 9) & 1) << 5)); }
__host__ __device__ __forceinline__ void stage_rc(int b, int& R, int& C) { const int st = b / 1024, sb = b % 1024, swz = sb ^ (((sb >> 9) & 1) << 5); R = (st >> 1) * 16 + swz / 64; C = (st & 1) * 32 + (swz % 64) / 2; }
__host__ __device__ __forceinline__ int perm32(int rho) { const int n = rho >> 4, i = rho & 15; return 8 * (i >> 2) + 4 * n + (i & 3); }

struct Unit { int pm, pn; };
struct Gemm { const bf16_t* A; const bf16_t* Bt; int M, N, K; };

struct StaticOrder {
    int nM, nN, nwg, G, c;
    __host__ __device__ void init(int M, int N, int G_, int c_) { nM = M / BM; nN = N / BM; nwg = nM * nN; G = G_; c = c_; }
    __host__ __device__ bool next(int i, Unit& u) const {
        const long L = (long)i * G + c; if (L >= nwg) return false;
        int wgid = (int)L; { const int q = nwg / NXCD, r = nwg % NXCD, xcd = wgid % NXCD, off = wgid / NXCD; wgid = (xcd < r ? xcd * (q + 1) : r * (q + 1) + (xcd - r) * q) + off; }
        const int nig = WGM * nN, gid = wgid / nig, fm = gid * WGM, gsz = (nM - fm) < WGM ? (nM - fm) : WGM;
        u.pm = fm + ((wgid % nig) % gsz); u.pn = (wgid % nig) / gsz; return true;
    }
    __device__ __forceinline__ void a_ready(const Unit&) const {}
    __device__ __forceinline__ void done(const Unit&) const {}
};

__device__ __forceinline__ unsigned cvt_pk_bf16(float lo, float hi) { unsigned r; asm volatile("v_cvt_pk_bf16_f32 %0, %1, %2" : "=v"(r) : "v"(lo), "v"(hi)); return r; }
typedef unsigned u32x2 __attribute__((ext_vector_type(2)));
typedef float f32x2 __attribute__((ext_vector_type(2)));
typedef __bf16 bf16x2_t __attribute__((ext_vector_type(2)));
__device__ __forceinline__ unsigned pk2(float lo, float hi) { f32x2 v = {lo, hi}; bf16x2_t b = __builtin_convertvector(v, bf16x2_t); return __builtin_bit_cast(unsigned, b); }
__device__ __forceinline__ float silu_f(float a) { return a * __builtin_amdgcn_rcpf(1.0f + __expf(-a)); }

struct EpiStoreBf16 {
    static constexpr bool PERM = true, AFTER_DRAIN = false;
    bf16_t* O; size_t ldc; const float* rowbias;
    __device__ __forceinline__ void operator()(const f32x4 (&acc)[2][2][4][2], const Unit& u, int wr, int wc, int fr, int fq) const {
        const int row0 = u.pm * BM + wr * 64 + fr; const int col0 = u.pn * BM + wc * 32 + 8 * fq;
#pragma unroll
        for (int ai = 0; ai < 2; ++ai)
#pragma unroll
            for (int m = 0; m < 4; ++m) { const int row = row0 + ai * HALF + m * 16; const float rb = rowbias ? rowbias[row] : 0.f; bf16_t* rowp = O + (size_t)row * ldc + col0;
#pragma unroll
                for (int bj = 0; bj < 2; ++bj) { const f32x4 v0 = acc[ai][bj][m][0] + rb, v1 = acc[ai][bj][m][1] + rb;
                    u32x4 w; w.x = pk2(v0[0], v0[1]); w.y = pk2(v0[2], v0[3]); w.z = pk2(v1[0], v1[1]); w.w = pk2(v1[2], v1[3]);
                    *(u32x4*)(rowp + bj * HALF) = w; } }
    }
};
struct EpiSwiGLU {
    static constexpr bool PERM = true, AFTER_DRAIN = false;
    bf16_t* H; int ldh;
    __device__ __forceinline__ void operator()(const f32x4 (&acc)[2][2][4][2], const Unit& u, int wr, int wc, int fr, int fq) const {
        const int row0 = u.pm * BM + wr * 64 + fr; const int col0 = u.pn * HALF + wc * 32 + 8 * fq;
#pragma unroll
        for (int ai = 0; ai < 2; ++ai)
#pragma unroll
            for (int m = 0; m < 4; ++m) { const int row = row0 + ai * HALF + m * 16;
                const f32x4 a0 = acc[ai][0][m][0], a1 = acc[ai][0][m][1], b0 = acc[ai][1][m][0], b1 = acc[ai][1][m][1];
                u32x4 w; w.x = pk2(silu_f(a0[0]) * b0[0], silu_f(a0[1]) * b0[1]); w.y = pk2(silu_f(a0[2]) * b0[2], silu_f(a0[3]) * b0[3]);
                w.z = pk2(silu_f(a1[0]) * b1[0], silu_f(a1[1]) * b1[1]); w.w = pk2(silu_f(a1[2]) * b1[2], silu_f(a1[3]) * b1[3]);
                *(u32x4*)(H + (size_t)row * ldh + col0) = w; }
    }
};
template <bool BASE_BF16, bool OUT_BF16> struct EpiResid {
    static constexpr bool PERM = true, AFTER_DRAIN = false;
    const void* base; void* out; const float* gate; const float* bias;
    __device__ __forceinline__ void operator()(const f32x4 (&acc)[2][2][4][2], const Unit& u, int wr, int wc, int fr, int fq) const {
        const int row0 = u.pm * BM + wr * 64 + fr; const int col0 = u.pn * BM + wc * 32 + 8 * fq;
        const float* gp = gate + (size_t)(u.pm >> 5) * 6144;
#pragma unroll
        for (int bj = 0; bj < 2; ++bj) { const int c = col0 + bj * HALF;
            const f32x4 g0 = *(const f32x4*)(gp + c), g1 = *(const f32x4*)(gp + c + 4);
            const f32x4 b0 = bias ? *(const f32x4*)(bias + c) : (f32x4){0.f, 0.f, 0.f, 0.f}, b1 = bias ? *(const f32x4*)(bias + c + 4) : (f32x4){0.f, 0.f, 0.f, 0.f};
#pragma unroll
            for (int ai = 0; ai < 2; ++ai)
#pragma unroll
                for (int m = 0; m < 4; ++m) { const size_t off = (size_t)(row0 + ai * HALF + m * 16) * 1024 + c;
                    f32x4 x0, x1;
                    if (BASE_BF16) { const u32x4 v = *(const u32x4*)((const bf16_t*)base + off);
                        x0 = (f32x4){__uint_as_float(v.x << 16), __uint_as_float(v.x & 0xffff0000u), __uint_as_float(v.y << 16), __uint_as_float(v.y & 0xffff0000u)};
                        x1 = (f32x4){__uint_as_float(v.z << 16), __uint_as_float(v.z & 0xffff0000u), __uint_as_float(v.w << 16), __uint_as_float(v.w & 0xffff0000u)}; }
                    else { x0 = *(const f32x4*)((const float*)base + off); x1 = *(const f32x4*)((const float*)base + off + 4); }
                    x0 = x0 + g0 * (acc[ai][bj][m][0] + b0); x1 = x1 + g1 * (acc[ai][bj][m][1] + b1);
                    if (OUT_BF16) { u32x4 w; w.x = pk2(x0[0], x0[1]); w.y = pk2(x0[2], x0[3]); w.z = pk2(x1[0], x1[1]); w.w = pk2(x1[2], x1[3]); *(u32x4*)((bf16_t*)out + off) = w; }
                    else { *(f32x4*)((float*)out + off) = x0; *(f32x4*)((float*)out + off + 4) = x1; } } }
    }
};
template <class Epi, class Sched, bool ALIGN_EPI = false, bool SP2 = false>
__device__ __forceinline__ void gemm_phase(PG8_LAS unsigned char* lds, const Gemm g, const Sched& S, const Epi& E) {
    const int tid = threadIdx.x, wid = __builtin_amdgcn_readfirstlane(tid >> 6), lane = tid & 63, wr = wid >> 2, wc = wid & 3, fr = lane & 15, fq = lane >> 4;
    const int K = g.K, nt = K / BK;
    unsigned voffA[2], voffB[2];
#pragma unroll
    for (int i = 0; i < 2; ++i) { int R, C; stage_rc(tid * 16 + i * 8192, R, C); const int Rb = Epi::PERM ? ((R & ~31) + perm32(R & 31)) : R;
        voffA[i] = (unsigned)(R * K + C) * 2u; voffB[i] = (unsigned)(Rb * K + C) * 2u; }
    const size_t kstep = (size_t)(BK * 2);
    const size_t hstep = (size_t)HALF * K * 2;
    const size_t tstep = 2 * hstep;
    const unsigned ldsw = (unsigned)wid * 1024u;
    const int aoff = lds_byte(wr * 64 + fr, fq * 8), boff = lds_byte(wc * 32 + fr, fq * 8);
#define PG8_SA(b, h) (((b) * 2 + (h)) * HTB)
#define PG8_SB(b, h) ((4 + (b) * 2 + (h)) * HTB)
#define PG8_STAGE(bufoff, gbase, voff) do { _Pragma("unroll") for (int _i = 0; _i < 2; ++_i) \
        __builtin_amdgcn_global_load_lds((const unsigned*)((const char*)(gbase) + (voff)[_i]), (PG8_LAS unsigned*)(lds + (bufoff) + ldsw + _i * 8192), 16, 0, 0); } while (0)
#define PG8_LDA(dst, b, h) do { _Pragma("unroll") for (int m = 0; m < 4; ++m) _Pragma("unroll") for (int k = 0; k < 2; ++k) dst[m][k] = *(const PG8_LAS bf16x8*)(lds + PG8_SA(b, h) + aoff + m * 2048 + k * 1024); } while (0)
#define PG8_LDB(dst, b, h) do { _Pragma("unroll") for (int n = 0; n < 2; ++n) _Pragma("unroll") for (int k = 0; k < 2; ++k) dst[n][k] = *(const PG8_LAS bf16x8*)(lds + PG8_SB(b, h) + boff + n * 2048 + k * 1024); } while (0)
#define PG8_MMA(ai, bj, At, Bt) do { __builtin_amdgcn_s_setprio(1); _Pragma("unroll") for (int m = 0; m < 4; ++m) _Pragma("unroll") for (int n = 0; n < 2; ++n) _Pragma("unroll") for (int k = 0; k < 2; ++k) \
        acc[ai][bj][m][n] = __builtin_amdgcn_mfma_f32_16x16x32_bf16(Bt[n][k], At[m][k], acc[ai][bj][m][n], 0, 0, 0); __builtin_amdgcn_s_setprio(0); } while (0)
#define PG8_WAIT_V(n) asm volatile("s_waitcnt vmcnt(" #n ")" ::: "memory")
#define PG8_WAIT_L(n) asm volatile("s_waitcnt lgkmcnt(" #n ")" ::: "memory")
#define PG8_BAR __builtin_amdgcn_s_barrier()
#define PG8_SCHED __builtin_amdgcn_sched_barrier(0)
    Unit cur, nxt; int ui = 0;
    if (!S.next(0, cur)) return;
    f32x4 acc[2][2][4][2];
#pragma unroll
    for (int a = 0; a < 2; ++a)
#pragma unroll
        for (int b = 0; b < 2; ++b)
#pragma unroll
            for (int m = 0; m < 4; ++m)
#pragma unroll
                for (int n = 0; n < 2; ++n) acc[a][b][m][n] = (f32x4){0.f, 0.f, 0.f, 0.f};
    bf16x8 At[4][2], B0[2][2], B1[2][2];
    const char* cA = (const char*)g.A + (size_t)cur.pm * tstep; const char* cB = (const char*)g.Bt + (size_t)cur.pn * tstep;
    S.a_ready(cur);
    if constexpr (SP2) {
        PG8_STAGE(PG8_SB(0, 0), cB, voffB); PG8_STAGE(PG8_SB(0, 1), cB + hstep, voffB); PG8_STAGE(PG8_SA(0, 0), cA, voffA); PG8_STAGE(PG8_SA(0, 1), cA + hstep, voffA);
        if (wr == 1) PG8_BAR;
        PG8_WAIT_V(2); PG8_BAR;
        PG8_STAGE(PG8_SB(1, 0), cB + kstep, voffB); PG8_STAGE(PG8_SA(1, 0), cA + kstep, voffA); PG8_STAGE(PG8_SB(1, 1), cB + hstep + kstep, voffB);
        PG8_WAIT_V(6); PG8_BAR;
    } else {
        PG8_STAGE(PG8_SB(0, 0), cB, voffB); PG8_STAGE(PG8_SA(0, 0), cA, voffA); PG8_STAGE(PG8_SB(0, 1), cB + hstep, voffB); PG8_STAGE(PG8_SA(0, 1), cA + hstep, voffA);
        if (wr == 1) PG8_BAR;
        PG8_WAIT_V(4); PG8_BAR;
        PG8_STAGE(PG8_SB(1, 0), cB + kstep, voffB); PG8_STAGE(PG8_SA(1, 0), cA + kstep, voffA); PG8_STAGE(PG8_SB(1, 1), cB + hstep + kstep, voffB);
        PG8_WAIT_V(6); PG8_BAR;
    }
    for (;;) {
        const bool has_next = S.next(ui + 1, nxt);
        const char* nA = has_next ? (const char*)g.A + (size_t)nxt.pm * tstep : cA; const char* nB = has_next ? (const char*)g.Bt + (size_t)nxt.pn * tstep : cB;
        for (int t = 0; t < nt; t += 2) {
            const bool last = (t == nt - 2);
            const char* a1 = cA + (size_t)(t + 1) * kstep;
            const char* a2 = last ? nA : cA + (size_t)(t + 2) * kstep; const char* b2 = last ? nB : cB + (size_t)(t + 2) * kstep;
            const char* a3 = a2 + kstep; const char* b3 = b2 + kstep;
            if (last && has_next) S.a_ready(nxt);
            if constexpr (SP2) {
            PG8_LDB(B0, 0, 0); PG8_LDB(B1, 0, 1); PG8_SCHED; PG8_LDA(At, 0, 0); PG8_STAGE(PG8_SA(1, 1), a1 + hstep, voffA);
            PG8_WAIT_V(8); PG8_WAIT_L(0); PG8_BAR; PG8_MMA(0, 0, At, B0); PG8_MMA(0, 1, At, B1); PG8_BAR; PG8_SCHED;
            PG8_LDA(At, 0, 1); PG8_STAGE(PG8_SB(0, 0), b2, voffB); PG8_STAGE(PG8_SB(0, 1), b2 + hstep, voffB); PG8_STAGE(PG8_SA(0, 0), a2, voffA);
            PG8_WAIT_V(8); PG8_WAIT_L(0); PG8_BAR; PG8_MMA(1, 0, At, B0); PG8_MMA(1, 1, At, B1); PG8_BAR; PG8_SCHED;
            PG8_LDB(B0, 1, 0); PG8_LDB(B1, 1, 1); PG8_SCHED; PG8_LDA(At, 1, 0); PG8_STAGE(PG8_SA(0, 1), a2 + hstep, voffA);
            PG8_WAIT_V(8); PG8_WAIT_L(0); PG8_BAR; PG8_MMA(0, 0, At, B0); PG8_MMA(0, 1, At, B1); PG8_BAR; PG8_SCHED;
            PG8_LDA(At, 1, 1); PG8_STAGE(PG8_SB(1, 0), b3, voffB); PG8_STAGE(PG8_SB(1, 1), b3 + hstep, voffB); PG8_STAGE(PG8_SA(1, 0), a3, voffA);
            PG8_WAIT_V(8); PG8_WAIT_L(0); PG8_BAR; PG8_MMA(1, 0, At, B0); PG8_MMA(1, 1, At, B1); PG8_BAR; PG8_SCHED;
            } else {
            PG8_LDB(B0, 0, 0); PG8_SCHED; PG8_LDA(At, 0, 0); PG8_STAGE(PG8_SA(1, 1), a1 + hstep, voffA);
            PG8_WAIT_L(8); PG8_BAR; PG8_WAIT_L(0); PG8_MMA(0, 0, At, B0); PG8_BAR; PG8_SCHED;
            PG8_LDB(B1, 0, 1); PG8_STAGE(PG8_SB(0, 0), b2, voffB);
            PG8_BAR; PG8_WAIT_L(0); PG8_MMA(0, 1, At, B1); PG8_BAR;
            PG8_LDA(At, 0, 1); PG8_STAGE(PG8_SA(0, 0), a2, voffA);
            PG8_BAR; PG8_WAIT_L(0); PG8_MMA(1, 0, At, B0); PG8_BAR; PG8_SCHED;
            PG8_STAGE(PG8_SB(0, 1), b2 + hstep, voffB);
            PG8_WAIT_V(6); PG8_BAR; PG8_MMA(1, 1, At, B1); PG8_BAR;
            PG8_LDB(B0, 1, 0); PG8_SCHED; PG8_LDA(At, 1, 0); PG8_STAGE(PG8_SA(0, 1), a2 + hstep, voffA);
            PG8_WAIT_L(8); PG8_BAR; PG8_WAIT_L(0); PG8_MMA(0, 0, At, B0); PG8_BAR; PG8_SCHED;
            PG8_LDB(B1, 1, 1); PG8_STAGE(PG8_SB(1, 0), b3, voffB);
            PG8_BAR; PG8_WAIT_L(0); PG8_MMA(0, 1, At, B1); PG8_BAR;
            PG8_LDA(At, 1, 1); PG8_STAGE(PG8_SA(1, 0), a3, voffA);
            PG8_BAR; PG8_WAIT_L(0); PG8_MMA(1, 0, At, B0); PG8_BAR; PG8_SCHED;
            PG8_STAGE(PG8_SB(1, 1), b3 + hstep, voffB);
            PG8_WAIT_V(6); PG8_BAR; PG8_MMA(1, 1, At, B1); PG8_BAR;
            }
        }
        if constexpr (ALIGN_EPI) { if (wr == 0) PG8_BAR; }
        if constexpr (!Epi::AFTER_DRAIN) { E(acc, cur, wr, wc, fr, fq); S.done(cur); }
        if (!has_next) break;
#pragma unroll
        for (int a = 0; a < 2; ++a)
#pragma unroll
            for (int b = 0; b < 2; ++b)
#pragma unroll
                for (int m = 0; m < 4; ++m)
#pragma unroll
                    for (int n = 0; n < 2; ++n) acc[a][b][m][n] = (f32x4){0.f, 0.f, 0.f, 0.f};
        cur = nxt; cA = nA; cB = nB; ++ui;
        if constexpr (ALIGN_EPI) { if (wr == 1) PG8_BAR; }
    }
    PG8_WAIT_V(0);
    if constexpr (!ALIGN_EPI) { if (wr == 0) PG8_BAR; }
    PG8_BAR;
    if constexpr (Epi::AFTER_DRAIN) { E.fused(acc, cur, wr, wc, fr, fq, lds, wid, lane); S.done(cur); }
#undef PG8_SA
#undef PG8_SB
#undef PG8_STAGE
#undef PG8_LDA
#undef PG8_LDB
#undef PG8_MMA
#undef PG8_WAIT_V
#undef PG8_WAIT_L
#undef PG8_BAR
#undef PG8_SCHED
}
}
#define LAS __attribute__((address_space(3)))
typedef pg8::bf16_t bf16_t;
typedef pg8::f32x4 f32x4;
typedef pg8::u32x4 u32x4;
typedef pg8::u32x2 u32x2;
typedef pg8::bf16x8 bf16x8;
typedef float cf __attribute__((ext_vector_type(2)));
typedef float f32x16 __attribute__((ext_vector_type(16)));
typedef short s16x4 __attribute__((ext_vector_type(4)));
using pg8::pk2;

constexpr int D_ = 1024, NBATCH = 8, SEQ = 8192, M_ = NBATCH * SEQ, LCTX = 256, MCTX = NBATCH * LCTX, MT_ = M_ + MCTX;
constexpr int NQKV = 1536, DFF = 2816, NFF1 = 2 * DFF, NFFT = 16384;
constexpr int NPHASE = 17;
constexpr size_t MiB = 1u << 20;
constexpr size_t WS_MOD = 0, WS_SD8 = 512 * 1024, WS_BAR = 768 * 1024, WS_ROPE = 1 * MiB, WS_HDN = 3 * MiB, WS_WQKV = 6 * MiB, WS_WO = 9 * MiB, WS_WFF1 = 11 * MiB, WS_WFF2 = 33 * MiB,
                 WS_WIN = 45 * MiB, WS_WOUT = 51 * MiB, WS_SD = 54 * MiB, WS_XN = 118 * MiB, WS_QKV = 250 * MiB, WS_OB = 448 * MiB, WS_ZT = 250 * MiB,
                 WS_H = 250 * MiB, WS_G = 634 * MiB, WS_GT = 118 * MiB, WS_XS = 762 * MiB, WS_END = 890 * MiB;
constexpr size_t ZLD = M_, GLD = M_;
constexpr int LDS_BYTES = 147456;

__device__ __forceinline__ float bf_lo(unsigned w) { return __uint_as_float(w << 16); }
__device__ __forceinline__ float bf_hi(unsigned w) { return __uint_as_float(w & 0xffff0000u); }
__device__ __forceinline__ float wave_sum(float v) {
#pragma unroll
    for (int o = 1; o < 64; o <<= 1) v += __shfl_xor(v, o);
    return v;
}

struct Args { const float* in[31]; float* out; unsigned char* ws; int ph_lo, ph_hi; };

__device__ __forceinline__ void transpose_item(const float* W, int K, int N, bf16_t* WT, int dst_row0, LAS float* scr, int k0, int n0, int lane) {
    float wv_[32];
#pragma unroll
    for (int i = 0; i < 32; ++i) { const int kk = 2 * i + (lane >> 5); wv_[i] = W[(size_t)(k0 + kk) * N + n0 + (lane & 31)]; }
#pragma unroll
    for (int i = 0; i < 32; ++i) { const int kk = 2 * i + (lane >> 5); scr[kk * 33 + (lane & 31)] = wv_[i]; }
    asm volatile("s_waitcnt lgkmcnt(0)" ::: "memory");
    const int c = lane & 7;
#pragma unroll
    for (int j = 0; j < 4; ++j) { const int n = (lane >> 3) + 8 * j; const LAS float* s = scr + (8 * c) * 33 + n;
        u32x4 o; o.x = pk2(s[0 * 33], s[1 * 33]); o.y = pk2(s[2 * 33], s[3 * 33]); o.z = pk2(s[4 * 33], s[5 * 33]); o.w = pk2(s[6 * 33], s[7 * 33]);
        *(u32x4*)(WT + (size_t)(dst_row0 + n) * K + k0 + 8 * c) = o; }
    asm volatile("s_waitcnt lgkmcnt(0)" ::: "memory");
}

struct TrP { const float* W; bf16_t* WT; int K, N, dr, k0, n0; };
__device__ __forceinline__ TrP tr_params(const Args& a, int it) {
    unsigned char* ws = a.ws; TrP p; int r = it;
#define TRP(Wp, KK, NN, WTp, MODE) { const int ni = ((KK) / 64) * ((NN) / 32); if (r < ni) { const int nblk = (NN) / 32, kb = r / nblk, nb = r % nblk, n0 = 32 * nb; \
        p.W = (Wp); p.WT = (bf16_t*)(WTp); p.K = (KK); p.N = (NN); p.k0 = 64 * kb; p.n0 = n0; p.dr = (MODE) == 0 ? n0 : (256 * (n0 / 128) + (n0 % 128) + ((MODE) == 2 ? 128 : 0)); return p; } r -= ni; }
    TRP(a.in[8], 1024, NQKV, ws + WS_WQKV, 0)
    TRP(a.in[9], 1024, 1024, ws + WS_WO, 0)
    TRP(a.in[28], 1024, DFF, ws + WS_WFF1, 1)
    TRP(a.in[29], 1024, DFF, ws + WS_WFF1, 2)
    TRP(a.in[28] + (size_t)1024 * DFF, 1024, DFF, ws + WS_WFF1 + 11 * MiB, 1)
    TRP(a.in[29] + (size_t)1024 * DFF, 1024, DFF, ws + WS_WFF1 + 11 * MiB, 2)
    TRP(a.in[30], DFF, 1024, ws + WS_WFF2, 0)
    TRP(a.in[30] + (size_t)1024 * DFF, DFF, 1024, ws + WS_WFF2 + 6 * MiB, 0)
    TRP(a.in[13], 1024, 3072, ws + WS_WIN, 0)
    { const int nblk = 32, kb = r / nblk, nb = r % nblk, n0 = 32 * nb; p.W = a.in[26]; p.WT = (bf16_t*)(ws + WS_WOUT); p.K = 1024; p.N = 1024; p.k0 = 64 * kb; p.n0 = n0; p.dr = n0; }
#undef TRP
    return p;
}
template <int SUB = 15> __device__ __forceinline__ void phase0(LAS unsigned char* L, const Args& a) {
    const int tid = threadIdx.x, lane = tid & 63, w = __builtin_amdgcn_readfirstlane(tid >> 6);
    const int bx = blockIdx.x, G = gridDim.x;
    unsigned char* ws = a.ws;
    if (SUB & 1) {
        LAS float* SC = (LAS float*)L;
        LAS float* RED = (LAS float*)(L + 9 * 1024 * 4);
        if (bx < 192) {
            const float* c = a.in[1]; const float* cc = a.in[3];
            for (int idx = tid; idx < 9 * 1024; idx += 512) { const int j = idx >> 10, k = idx & 1023; const float v = j < 8 ? c[j * 1024 + k] : cc[k]; SC[idx] = v / (1.0f + expf(-v)); }
            __syncthreads();
            float* MOD = (float*)(ws + WS_MOD);
            for (int unit = bx; unit < 192; unit += G) {
                const int l = unit / 96, ng = unit % 96, n = ng * 64 + lane;
                const float* aw = a.in[4] + (size_t)l * 1024 * 6144 + n;
                float acc[9];
#pragma unroll
                for (int j = 0; j < 9; ++j) acc[j] = 0.f;
#pragma unroll 1
                for (int kb = 0; kb < 128; kb += 32) { float wv[32];
#pragma unroll
                    for (int kk = 0; kk < 32; ++kk) wv[kk] = aw[(size_t)(w * 128 + kb + kk) * 6144];
#pragma unroll
                    for (int kk = 0; kk < 32; ++kk) { const int k = w * 128 + kb + kk;
#pragma unroll
                        for (int j = 0; j < 9; ++j) acc[j] += SC[j * 1024 + k] * wv[kk]; } }
#pragma unroll
                for (int j = 0; j < 9; ++j) RED[(w * 9 + j) * 64 + lane] = acc[j];
                __syncthreads();
                for (int idx = tid; idx < 576; idx += 512) { const int j = idx >> 6, nn = idx & 63; float s = 0.f;
#pragma unroll
                    for (int ww = 0; ww < 8; ++ww) s += RED[(ww * 9 + j) * 64 + nn];
                    MOD[(size_t)(l * 9 + j) * 6144 + ng * 64 + nn] = s + a.in[5][l * 6144 + ng * 64 + nn]; }
                __syncthreads();
            }
        }
        __syncthreads();
    }
    if (SUB & 2) {
        LAS float* ZB = (LAS float*)L;
        LAS float* H1 = (LAS float*)(L + 2048);
        LAS float* W1L = (LAS float*)(L + 4096);
        LAS float* W2L = (LAS float*)(L + 4096 + 33 * 64 * 4);
        for (int idx = tid; idx < 33 * 64; idx += 512) W1L[idx] = a.in[17][idx];
        for (int idx = tid; idx < 64 * 64; idx += 512) W2L[idx] = a.in[20][idx];
        __syncthreads();
        bf16_t* HDN = (bf16_t*)(ws + WS_HDN);
        const float* b1 = a.in[18]; const float* f1 = a.in[19]; const float* b2 = a.in[21]; const float* f2 = a.in[22];
        const int pos = w, j = lane;
        for (int unit = bx; unit < 1024; unit += G) {
            const int m = unit * 8 + pos;
            if (lane < 33) {
                float zv;
                if (lane == 0) zv = (float)m / (float)(SEQ - 1);
                else { const int i = (lane - 1) & 15; const float band = 1e-4f + (float)i * ((15.0f - 1e-4f) / 15.0f); const float wm = 6.283185307179586f * (float)m / (float)SEQ; const float ang = band * wm;
                    zv = (lane <= 16) ? __cosf(ang) : -__sinf(ang); }
                ZB[pos * 36 + lane] = zv;
            }
            __syncthreads();
            float s = b1[j];
#pragma unroll
            for (int e = 0; e < 33; ++e) s += ZB[pos * 36 + e] * W1L[e * 64 + j];
            H1[pos * 64 + j] = __sinf(f1[j] * s);
            __syncthreads();
            float s2 = b2[j];
#pragma unroll 8
            for (int e = 0; e < 64; ++e) s2 += H1[pos * 64 + e] * W2L[e * 64 + j];
            HDN[(size_t)m * 64 + j] = (bf16_t)(pk2(__sinf(f2[j] * s2), 0.f) & 0xffffu);
            __syncthreads();
        }
    }
    if (SUB & 4) {
        LAS float* scr = (LAS float*)(L + w * 16384);
        const int gw = bx * 8 + w, NGW = G * 8;
        constexpr int I_QKV = 16 * (NQKV / 32), I_SQ = 16 * 32, I_F1 = 16 * (DFF / 32), I_F2 = (DFF / 64) * 32, I_IN = 16 * (3072 / 32);
        constexpr int NITEMS = I_QKV + I_SQ + 4 * I_F1 + 2 * I_F2 + I_IN + I_SQ;
        float wv[32]; TrP cur = tr_params(a, gw < NITEMS ? gw : 0);
#define TR_LOAD(p_) do { _Pragma("unroll") for (int i = 0; i < 32; ++i) { const int kk = 2 * i + (lane >> 5); wv[i] = (p_).W[(size_t)((p_).k0 + kk) * (p_).N + (p_).n0 + (lane & 31)]; } } while (0)
        if (gw < NITEMS) TR_LOAD(cur);
        for (int it = gw; it < NITEMS; it += NGW) {
#pragma unroll
            for (int i = 0; i < 32; ++i) { const int kk = 2 * i + (lane >> 5); scr[kk * 33 + (lane & 31)] = wv[i]; }
            TrP nxt = cur;
            if (it + NGW < NITEMS) { nxt = tr_params(a, it + NGW); TR_LOAD(nxt); }
            asm volatile("s_waitcnt lgkmcnt(0)" ::: "memory");
            const int c = lane & 7;
#pragma unroll
            for (int j = 0; j < 4; ++j) { const int n = (lane >> 3) + 8 * j; const LAS float* sp = scr + (8 * c) * 33 + n;
                u32x4 o; o.x = pk2(sp[0 * 33], sp[1 * 33]); o.y = pk2(sp[2 * 33], sp[3 * 33]); o.z = pk2(sp[4 * 33], sp[5 * 33]); o.w = pk2(sp[6 * 33], sp[7 * 33]);
                *(u32x4*)(cur.WT + (size_t)(cur.dr + n) * cur.K + cur.k0 + 8 * c) = o; }
            asm volatile("s_waitcnt lgkmcnt(0)" ::: "memory");
            cur = nxt;
        }
#undef TR_LOAD
    }
    if (SUB & 8) {
        float* ROPE = (float*)(ws + WS_ROPE);
        for (int idx = bx * 512 + tid; idx < SEQ * 32; idx += G * 512) { const int t = idx >> 5, i = idx & 31; const int pos = (i < 16) ? (t >> 6) : (t & 63); const int f = i & 15;
            const float inv = powf(10000.0f, -(float)f / 16.0f); const float ang = (float)pos * inv; ROPE[t * 64 + i] = cosf(ang); ROPE[t * 64 + 32 + i] = sinf(ang); }
    }
}

__device__ __forceinline__ int PH(int p) { return p ^ (((p >> 6) & 15) << 2); }
__device__ __forceinline__ cf cmul(cf a, cf b) { cf t, r;
    asm("v_pk_mul_f32 %0, %1, %2 op_sel:[0,0] op_sel_hi:[0,1]" : "=v"(t) : "v"(a), "v"(b));
    asm("v_pk_fma_f32 %0, %1, %2, %3 op_sel:[1,1,0] op_sel_hi:[1,0,1] neg_lo:[1,0,0]" : "=v"(r) : "v"(a), "v"(b), "v"(t)); return r; }
__device__ __forceinline__ cf cmulc(cf a, cf b) { cf t, r;
    asm("v_pk_mul_f32 %0, %1, %2 op_sel:[0,0] op_sel_hi:[0,1] neg_hi:[0,1]" : "=v"(t) : "v"(a), "v"(b));
    asm("v_pk_fma_f32 %0, %1, %2, %3 op_sel:[1,1,0] op_sel_hi:[1,0,1]" : "=v"(r) : "v"(a), "v"(b), "v"(t)); return r; }
__device__ __forceinline__ cf cconj(cf a) { return (cf){a.x, -a.y}; }
__device__ __forceinline__ cf add_mib(cf a, cf b) { cf r; asm("v_pk_add_f32 %0, %1, %2 op_sel:[0,1] op_sel_hi:[1,0] neg_hi:[0,1]" : "=v"(r) : "v"(a), "v"(b)); return r; }
__device__ __forceinline__ cf add_pib(cf a, cf b) { cf r; asm("v_pk_add_f32 %0, %1, %2 op_sel:[0,1] op_sel_hi:[1,0] neg_lo:[0,1]" : "=v"(r) : "v"(a), "v"(b)); return r; }
template <bool INV> __device__ __forceinline__ void dft4(cf& a0, cf& a1, cf& a2, cf& a3) {
    const cf s0 = a0 + a2, s1 = a0 - a2, s2 = a1 + a3, s3 = a1 - a3;
    a0 = s0 + s2; a2 = s0 - s2;
    if (!INV) { a1 = add_mib(s1, s3); a3 = add_pib(s1, s3); }
    else      { a1 = add_pib(s1, s3); a3 = add_mib(s1, s3); }
}
template <bool INV> __device__ __forceinline__ cf tw16(cf v, float c, float s) {
    const float ss = INV ? s : -s; return (cf){v.x * c - v.y * ss, v.x * ss + v.y * c};
}
template <bool INV, bool HALFIN = false> __device__ __forceinline__ void dft16(cf (&x)[16]) {
#pragma unroll
    for (int m2 = 0; m2 < 4; ++m2) {
        if (HALFIN) { const cf a0 = x[m2], a1 = x[4 + m2]; x[m2] = a0 + a1; x[8 + m2] = a0 - a1; x[4 + m2] = add_mib(a0, a1); x[12 + m2] = add_pib(a0, a1); }
        else dft4<INV>(x[m2], x[4 + m2], x[8 + m2], x[12 + m2]);
    }
    constexpr float C1 = 0.9238795325112867f, S1 = 0.3826834323650898f, C2 = 0.7071067811865476f;
    x[4 * 1 + 1] = tw16<INV>(x[5], C1, S1);  x[4 * 1 + 2] = tw16<INV>(x[6], C2, C2);   x[4 * 1 + 3] = tw16<INV>(x[7], S1, C1);
    x[4 * 2 + 1] = tw16<INV>(x[9], C2, C2);  x[4 * 2 + 2] = tw16<INV>(x[10], 0.f, 1.f); x[4 * 2 + 3] = tw16<INV>(x[11], -C2, C2);
    x[4 * 3 + 1] = tw16<INV>(x[13], S1, C1); x[4 * 3 + 2] = tw16<INV>(x[14], -C2, C2); x[4 * 3 + 3] = tw16<INV>(x[15], -C1, -S1);
#pragma unroll
    for (int q1 = 0; q1 < 4; ++q1) dft4<INV>(x[4 * q1], x[4 * q1 + 1], x[4 * q1 + 2], x[4 * q1 + 3]);
}
template <int LST> __device__ __forceinline__ int pass_pos(int base, int phb, int m) {
    if (LST == 10) return phb + (m << 10);
    if (LST == 6) return (base ^ (m << 2)) + (m << 6);
    return PH(base + (m << LST));
}
template <bool INV, int LST, bool HALF = false> __device__ __forceinline__ void fft_pass16(LAS cf* z, const LAS cf* Thi, const LAS cf* Tlo, int tid) {
    constexpr int st = 1 << LST;
    cf w[16];
#pragma unroll 1
    for (int it = 0; it < 2; ++it) {
        const int g = tid + 512 * it; const int j0 = g & (st - 1); const int base = ((g >> LST) << (LST + 4)) + j0; const int phb = PH(base);
        if (LST == 10 || it == 0) {
            const int e1 = j0 << (10 - LST);
            w[1] = cmul(Thi[e1 >> 7], Tlo[e1 & 127]);
            w[2] = cmul(w[1], w[1]); w[3] = cmul(w[2], w[1]); w[4] = cmul(w[2], w[2]); w[5] = cmul(w[4], w[1]); w[6] = cmul(w[3], w[3]); w[7] = cmul(w[4], w[3]); w[8] = cmul(w[4], w[4]);
#pragma unroll
            for (int q = 9; q < 16; ++q) w[q] = cmul(w[8], w[q - 8]);
        }
        cf x[16];
        if (!INV) {
#pragma unroll
            for (int m = 0; m < 16; ++m) { if (HALF && m >= 8) x[m] = (cf){0.f, 0.f}; else x[m] = z[pass_pos<LST>(base, phb, m)]; }
            dft16<false, HALF>(x);
#pragma unroll
            for (int q = 0; q < 16; ++q) { cf y = x[4 * (q & 3) + (q >> 2)]; if (q) y = cmul(y, w[q]); z[pass_pos<LST>(base, phb, q)] = y; }
        } else {
#pragma unroll
            for (int q = 0; q < 16; ++q) { cf y = z[pass_pos<LST>(base, phb, q)]; if (q) y = cmulc(y, w[q]); x[q] = y; }
            dft16<true>(x);
#pragma unroll
            for (int m = 0; m < (HALF ? 8 : 16); ++m) z[pass_pos<LST>(base, phb, m)] = x[4 * (m & 3) + (m >> 2)];
        }
    }
    __syncthreads();
}
template <bool INV> __device__ __forceinline__ void fft_pass4(LAS cf* z, int tid) {
#pragma unroll 2
    for (int it = 0; it < 8; ++it) {
        const int g = tid + 512 * it; const int pb = PH(4 * g);
        f32x4 v0 = *(LAS f32x4*)(z + pb), v1 = *(LAS f32x4*)(z + pb + 2);
        cf a0 = {v0[0], v0[1]}, a1 = {v0[2], v0[3]}, a2 = {v1[0], v1[1]}, a3 = {v1[2], v1[3]};
        dft4<INV>(a0, a1, a2, a3);
        *(LAS f32x4*)(z + pb) = (f32x4){a0.x, a0.y, a1.x, a1.y}; *(LAS f32x4*)(z + pb + 2) = (f32x4){a2.x, a2.y, a3.x, a3.y};
    }
    __syncthreads();
}
__device__ __forceinline__ void fft_forward(LAS cf* z, const LAS cf* Thi, const LAS cf* Tlo, int tid) {
    fft_pass16<false, 10>(z, Thi, Tlo, tid); fft_pass16<false, 6>(z, Thi, Tlo, tid); fft_pass16<false, 2>(z, Thi, Tlo, tid); fft_pass4<false>(z, tid);
}
__device__ __forceinline__ void fft_inverse(LAS cf* z, const LAS cf* Thi, const LAS cf* Tlo, int tid) {
    fft_pass4<true>(z, tid); fft_pass16<true, 2>(z, Thi, Tlo, tid); fft_pass16<true, 6>(z, Thi, Tlo, tid); fft_pass16<true, 10>(z, Thi, Tlo, tid);
}
__device__ __forceinline__ int k_of_p(int p) { return (p >> 10) | (((p >> 6) & 15) << 4) | (((p >> 2) & 15) << 8) | ((p & 3) << 12); }
__device__ __forceinline__ int p_of_k(int k) { return ((k & 15) << 10) | (((k >> 4) & 15) << 6) | (((k >> 8) & 15) << 2) | (k >> 12); }
__device__ __forceinline__ void fft_tables(LAS cf* Thi, LAS cf* Tlo, int tid) {
    if (tid < 256) { const int aidx = tid & 127; const float ang = (tid < 128) ? (-6.283185307179586f * (float)aidx / 128.0f) : (-6.283185307179586f * (float)aidx / 16384.0f);
        float s, c; sincosf(ang, &s, &c); if (tid < 128) Thi[aidx] = (cf){c, s}; else Tlo[aidx] = (cf){c, s}; }
    __syncthreads();
}

__device__ __forceinline__ void filter_phase(LAS unsigned char* L, const Args& a) {
    const int tid = threadIdx.x;
    LAS cf* z = (LAS cf*)L; LAS cf* Thi = (LAS cf*)(L + 131072); LAS cf* Tlo = Thi + 128;
    LAS float* WT = (LAS float*)(L + 131072 + 2048);
    LAS float* RS = WT + 512;
    const bf16_t* HDN = (const bf16_t*)(a.ws + WS_HDN); const float* wout = a.in[23]; const float* decay = a.in[24];
    f32x4* SD = (f32x4*)(a.ws + WS_SD); f32x4* SD8 = (f32x4*)(a.ws + WS_SD8);
    fft_tables(Thi, Tlo, tid);
    for (int pair = blockIdx.x; pair < 512; pair += gridDim.x) {
        const int ca = 2 * pair;
        {
            LAS bf16_t* WTt = (LAS bf16_t*)WT;
            for (int idx = tid; idx < 1024; idx += 512) { const int n = idx >> 6, k = idx & 63;
                const float v = (n < 4) ? wout[(size_t)k * 2048 + ((n & 2) ? 1024 : 0) + ca + (n & 1)] : 0.f; WTt[idx] = (bf16_t)(pk2(v, 0.f) & 0xffffu); }
        }
        __syncthreads();
        const float da = fabsf(decay[ca]), db = fabsf(decay[ca + 1]);
        float sa = 0.f, sb = 0.f;
        {
            const int lane = tid & 63, w = tid >> 6, n = lane & 15, q = lane >> 4;
            const bf16x8 b0 = *(const LAS bf16x8*)((const LAS bf16_t*)WT + n * 64 + 8 * q), b1 = *(const LAS bf16x8*)((const LAS bf16_t*)WT + n * 64 + 32 + 8 * q);
            const float dsel = (n & 1) ? db : da; float ssum = 0.f;
            LAS float* zf = (LAS float*)z;
#pragma unroll 1
            for (int mg = 0; mg < 4; ++mg) {
            bf16x8 a0v[16], a1v[16];
#pragma unroll
            for (int u = 0; u < 16; ++u) { const bf16_t* hp = HDN + (size_t)(16 * (w + 8 * (mg * 16 + u)) + n) * 64 + 8 * q; a0v[u] = *(const bf16x8*)hp; a1v[u] = *(const bf16x8*)(hp + 32); }
#pragma unroll
            for (int u = 0; u < 16; ++u) {
                const int mt = w + 8 * (mg * 16 + u); const int m0 = 16 * mt; const bf16x8 a0 = a0v[u], a1 = a1v[u];
                f32x4 acc = {0.f, 0.f, 0.f, 0.f};
                acc = __builtin_amdgcn_mfma_f32_16x16x32_bf16(a0, b0, acc, 0, 0, 0); acc = __builtin_amdgcn_mfma_f32_16x16x32_bf16(a1, b1, acc, 0, 0, 0);
                {
                    const int ml = lane >> 2, nn = lane & 3, src = nn + 16 * (ml >> 2);
                    const float v0 = __shfl(acc[0], src), v1 = __shfl(acc[1], src), v2 = __shfl(acc[2], src), v3 = __shfl(acc[3], src);
                    const int isel = ml & 3; float v = isel == 0 ? v0 : isel == 1 ? v1 : isel == 2 ? v2 : v3;
                    const int m = m0 + ml; const float t = (float)m / (float)(SEQ - 1); v *= expf(-t * ((nn & 1) ? db : da));
                    if (nn < 2) { zf[2 * PH(m) + nn] = v; ssum += fabsf(v); }
                    else if (m >= 1) { zf[2 * PH(NFFT - m) + (nn - 2)] = v; ssum += fabsf(v); }
                }
            }
            }
            if (tid == 0) z[PH(SEQ)] = (cf){0.f, 0.f};
            sa = !(lane & 1) ? ssum : 0.f; sb = (lane & 1) ? ssum : 0.f;
        }
        sa = wave_sum(sa); sb = wave_sum(sb);
        if ((tid & 63) == 0) { RS[(tid >> 6) * 2] = sa; RS[(tid >> 6) * 2 + 1] = sb; }
        __syncthreads();
        float ta = 0.f, tb = 0.f;
#pragma unroll
        for (int ww = 0; ww < 8; ++ww) { ta += RS[ww * 2]; tb += RS[ww * 2 + 1]; }
        const float na = 1.0f / (ta * (float)NFFT), nb = 1.0f / (tb * (float)NFFT);
        fft_forward(z, Thi, Tlo, tid);
#define FILT_SD(zk, zn, OUT) do { const cf A_ = (cf){0.5f * ((zk).x + (zn).x), 0.5f * ((zk).y - (zn).y)}; const cf t2_ = (cf){0.5f * ((zk).x - (zn).x), 0.5f * ((zk).y + (zn).y)}; \
            const cf B_ = (cf){t2_.y, -t2_.x}; const cf Ka_ = A_ * na, Kb_ = B_ * nb; \
            OUT = (f32x4){0.5f * (Ka_.x + Kb_.x), 0.5f * (Ka_.y + Kb_.y), 0.5f * (Ka_.x - Kb_.x), 0.5f * (Ka_.y - Kb_.y)}; } while (0)
#pragma unroll
        for (int i = 0; i < 8; ++i) {
            const int g = tid + 512 * i;
            const int kg = (g >> 8) | (((g >> 4) & 15) << 4) | ((g & 15) << 8);
            const int pp0 = p_of_k((NFFT - kg) & (NFFT - 1)), pp1 = p_of_k(12288 - kg);
            const f32x4 zz = *(LAS f32x4*)(z + PH(4 * g));
            const cf zk0 = {zz[0], zz[1]}, zk1 = {zz[2], zz[3]}; const cf zn0 = z[PH(pp0)], zn1 = z[PH(pp1)];
            f32x4 o0, o1; FILT_SD(zk0, zn0, o0); FILT_SD(zk1, zn1, o1);
            f32x4* dst = SD + (size_t)pair * 8192 + 2 * g; dst[0] = o0; dst[1] = o1;
        }
        if (tid == 0) { const cf zk = z[PH(2)]; f32x4 o; FILT_SD(zk, zk, o); SD8[pair] = o; }
#undef FILT_SD
        __syncthreads();
    }
}

__device__ __forceinline__ void norm_rows(const float* x, int nrows, const float* g, const float* sc, const float* sh, bf16_t* o, int lane) {
    f32x4 gs[4], shv[4];
#pragma unroll
    for (int j = 0; j < 4; ++j) { const int k = 4 * lane + 256 * j; const f32x4 gg = *(const f32x4*)(g + k), s = *(const f32x4*)(sc + k); gs[j] = gg * (1.0f + s); shv[j] = *(const f32x4*)(sh + k); }
    int r0 = 0;
#pragma unroll 1
    for (; r0 + 4 <= nrows; r0 += 4) {
        f32x4 v[4][4];
#pragma unroll
        for (int rr = 0; rr < 4; ++rr) { const f32x4* xr = (const f32x4*)(x + (size_t)(r0 + rr) * 1024) + lane;
#pragma unroll
            for (int j = 0; j < 4; ++j) v[rr][j] = xr[64 * j]; }
#pragma unroll
        for (int rr = 0; rr < 4; ++rr) { float ss = 0.f;
#pragma unroll
            for (int j = 0; j < 4; ++j) ss += (v[rr][j].x * v[rr][j].x + v[rr][j].y * v[rr][j].y) + (v[rr][j].z * v[rr][j].z + v[rr][j].w * v[rr][j].w);
            const float rstd = rsqrtf(wave_sum(ss) * (1.0f / 1024.0f) + 1e-6f);
            u32x2* op = (u32x2*)(o + (size_t)(r0 + rr) * 1024) + lane;
#pragma unroll
            for (int j = 0; j < 4; ++j) { const f32x4 y = v[rr][j] * rstd * gs[j] + shv[j]; u32x2 wv; wv.x = pk2(y.x, y.y); wv.y = pk2(y.z, y.w); op[64 * j] = wv; } }
    }
    for (int r = r0; r < nrows; ++r) {
        const f32x4* xr = (const f32x4*)(x + (size_t)r * 1024) + lane; f32x4 v[4]; float ss = 0.f;
#pragma unroll
        for (int j = 0; j < 4; ++j) { v[j] = xr[64 * j]; ss += (v[j].x * v[j].x + v[j].y * v[j].y) + (v[j].z * v[j].z + v[j].w * v[j].w); }
        const float rstd = rsqrtf(wave_sum(ss) * (1.0f / 1024.0f) + 1e-6f);
        u32x2* op = (u32x2*)(o + (size_t)r * 1024) + lane;
#pragma unroll
        for (int j = 0; j < 4; ++j) { const f32x4 y = v[j] * rstd * gs[j] + shv[j]; u32x2 wv; wv.x = pk2(y.x, y.y); wv.y = pk2(y.z, y.w); op[64 * j] = wv; }
    }
}
__device__ __forceinline__ void norm_rows_bf16(const bf16_t* x, int nrows, const float* g, const float* sc, const float* sh, bf16_t* o, int lane) {
    f32x4 gs[4], shv[4];
#pragma unroll
    for (int j = 0; j < 4; ++j) { const int k = 8 * lane + 512 * (j >> 1) + 4 * (j & 1); const f32x4 gg = *(const f32x4*)(g + k), s = *(const f32x4*)(sc + k); gs[j] = gg * (1.0f + s); shv[j] = *(const f32x4*)(sh + k); }
#pragma unroll 1
    for (int r0 = 0; r0 < nrows; r0 += 8) {
        u32x4 raw[8][2];
#pragma unroll
        for (int rr = 0; rr < 8; ++rr) { const u32x4* xr = (const u32x4*)(x + (size_t)(r0 + rr) * 1024) + lane; raw[rr][0] = xr[0]; raw[rr][1] = xr[64]; }
        float rs[8];
#pragma unroll
        for (int rr = 0; rr < 8; ++rr) { float ss = 0.f;
#pragma unroll
            for (int j = 0; j < 2; ++j) { const u32x4 t = raw[rr][j]; const float e0 = bf_lo(t.x), e1 = bf_hi(t.x), e2 = bf_lo(t.y), e3 = bf_hi(t.y), e4 = bf_lo(t.z), e5 = bf_hi(t.z), e6 = bf_lo(t.w), e7 = bf_hi(t.w);
                ss += (e0 * e0 + e1 * e1) + (e2 * e2 + e3 * e3) + (e4 * e4 + e5 * e5) + (e6 * e6 + e7 * e7); }
            rs[rr] = ss; }
#pragma unroll
        for (int of = 1; of < 64; of <<= 1) {
#pragma unroll
            for (int rr = 0; rr < 8; ++rr) rs[rr] += __shfl_xor(rs[rr], of); }
#pragma unroll
        for (int rr = 0; rr < 8; ++rr) { const float rstd = rsqrtf(rs[rr] * (1.0f / 1024.0f) + 1e-6f);
            u32x4* op = (u32x4*)(o + (size_t)(r0 + rr) * 1024) + lane;
#pragma unroll
            for (int j = 0; j < 2; ++j) { const u32x4 t = raw[rr][j];
                const f32x4 v0 = (f32x4){bf_lo(t.x), bf_hi(t.x), bf_lo(t.y), bf_hi(t.y)}, v1 = (f32x4){bf_lo(t.z), bf_hi(t.z), bf_lo(t.w), bf_hi(t.w)};
                const f32x4 y0 = v0 * rstd * gs[2 * j] + shv[2 * j], y1 = v1 * rstd * gs[2 * j + 1] + shv[2 * j + 1];
                u32x4 wv; wv.x = pk2(y0.x, y0.y); wv.y = pk2(y0.z, y0.w); wv.z = pk2(y1.x, y1.y); wv.w = pk2(y1.z, y1.w); op[64 * j] = wv; }
            __builtin_amdgcn_sched_barrier(0); }
    }
}
__device__ __forceinline__ void norm_phase_bf16(const Args& a, int layer, int which) {
    const int tid = threadIdx.x, lane = tid & 63, w = tid >> 6; const int gw = blockIdx.x * 8 + w, NGW = gridDim.x * 8;
    const float* MOD = (const float*)(a.ws + WS_MOD) + (size_t)layer * 9 * 6144;
    const float* g = (which ? a.in[7] : a.in[6]) + layer * 1024;
    bf16_t* XN = (bf16_t*)(a.ws + WS_XN); const bf16_t* XS = (const bf16_t*)(a.ws + WS_XS);
    const int c0 = which ? 3 : 0;
    for (int chunk = gw; chunk < M_ / 32; chunk += NGW) { const int row = chunk * 32, b = row / SEQ; const float* mb = MOD + (size_t)b * 6144;
        norm_rows_bf16(XS + (size_t)row * 1024, 32, g, mb + (c0 + 1) * 1024, mb + c0 * 1024, XN + (size_t)row * 1024, lane); }
}
__device__ __forceinline__ void norm_phase(const Args& a, const float* x, int layer, int which  , bool with_ctx) {
    const int tid = threadIdx.x, lane = tid & 63, w = tid >> 6; const int gw = blockIdx.x * 8 + w, NGW = gridDim.x * 8;
    const float* MOD = (const float*)(a.ws + WS_MOD) + (size_t)layer * 9 * 6144;
    const float* g = (which ? a.in[7] : a.in[6]) + layer * 1024;
    bf16_t* XN = (bf16_t*)(a.ws + WS_XN);
    const int c0 = which ? 3 : 0;
    for (int chunk = gw; chunk < M_ / 32; chunk += NGW) { const int row = chunk * 32, b = row / SEQ; const float* mb = MOD + (size_t)b * 6144;
        norm_rows(x + (size_t)row * 1024, 32, g, mb + (c0 + 1) * 1024, mb + c0 * 1024, XN + (size_t)row * 1024, lane); }
    if (with_ctx) { const float* mb = MOD + (size_t)8 * 6144;
        for (int row = gw; row < MCTX; row += NGW) norm_rows(a.in[2] + (size_t)row * 1024, 1, g, mb + (c0 + 1) * 1024, mb + c0 * 1024, XN + (size_t)(M_ + row) * 1024, lane); }
}

__device__ __forceinline__ void kprep_phase(const Args& a) {
    const int tid = threadIdx.x, lane = tid & 63, w = tid >> 6; const int gw = blockIdx.x * 8 + w, NGW = gridDim.x * 8;
    bf16_t* QKV = (bf16_t*)(a.ws + WS_QKV); const float* ROPE = (const float*)(a.ws + WS_ROPE); const float* kgain = a.in[11];
    const int d4 = 4 * (lane & 15); const f32x4 g = *(const f32x4*)(kgain + d4); const bool lowhalf = (lane & 8) == 0; const int j = d4 & 31;
#pragma unroll 2
    for (int row = gw; row < MT_; row += NGW) {
        u32x2* p = (u32x2*)(QKV + (size_t)row * NQKV + 1024 + 4 * lane);
        const u32x2 v = *p; float f0 = bf_lo(v.x), f1 = bf_hi(v.x), f2 = bf_lo(v.y), f3 = bf_hi(v.y);
        float ss = (f0 * f0 + f1 * f1) + (f2 * f2 + f3 * f3);
        ss += __shfl_xor(ss, 1); ss += __shfl_xor(ss, 2); ss += __shfl_xor(ss, 4); ss += __shfl_xor(ss, 8);
        const float rstd = rsqrtf(ss * (1.0f / 64.0f) + 1e-6f);
        f0 *= rstd * g[0]; f1 *= rstd * g[1]; f2 *= rstd * g[2]; f3 *= rstd * g[3];
        if (row < M_) {
            const float p0 = __shfl_xor(f0, 8), p1 = __shfl_xor(f1, 8), p2 = __shfl_xor(f2, 8), p3 = __shfl_xor(f3, 8);
            const float* rp = ROPE + (size_t)(row & (SEQ - 1)) * 64 + j; const f32x4 cs = *(const f32x4*)rp, sn = *(const f32x4*)(rp + 32);
            if (lowhalf) { f0 = f0 * cs[0] - p0 * sn[0]; f1 = f1 * cs[1] - p1 * sn[1]; f2 = f2 * cs[2] - p2 * sn[2]; f3 = f3 * cs[3] - p3 * sn[3]; }
            else         { f0 = p0 * sn[0] + f0 * cs[0]; f1 = p1 * sn[1] + f1 * cs[1]; f2 = p2 * sn[2] + f2 * cs[2]; f3 = p3 * sn[3] + f3 * cs[3]; }
        }
        u32x2 o; o.x = pk2(f0, f1); o.y = pk2(f2, f3); *p = o;
    }
}

__device__ __forceinline__ int crow(int r, int hi) { return (r & 3) + 8 * (r >> 2) + 4 * hi; }
template <int MODE = 3> __device__ __forceinline__ void attn_phase(LAS unsigned char* L, const Args& a, int vcu, int G) {
    const int tid = threadIdx.x, lane = tid & 63, w = __builtin_amdgcn_readfirstlane(tid >> 6), r32 = lane & 31, hi = lane >> 5;
    constexpr int KS = 144, VS = 136, KBYTES = 64 * KS, VBYTES = 64 * VS, VOFF = 2 * KBYTES;
    const bf16_t* QKV = (const bf16_t*)(a.ws + WS_QKV); bf16_t* OB = (bf16_t*)(a.ws + WS_OB); const float* ROPE = (const float*)(a.ws + WS_ROPE);
    const float* qgain = a.in[10]; const float* sink = a.in[12];
    const float C2 = 0.125f * 1.4426950408889634f;
    const int krow = w * 8 + (lane >> 3), kch = lane & 7;
    for (int unit = vcu; unit < 4096; unit += G) {
        const int b = unit >> 9, kvh = (unit >> 7) & 3, qb = unit & 127, q0 = qb * 64;
        const int head = kvh * 4 + (w & 3), qrow = q0 + 32 * (w >> 2) + r32;
        const int jlo = (q0 < 128) ? ((128 - q0) >> 6) : 0; const int jhi = (q0 > SEQ - 192) ? ((SEQ + 64 - q0) >> 6) : 4; const int ntiles = 4 + (jhi - jlo + 1);
        bf16x8 qr[4];
        {
            const bf16_t* qp = QKV + (size_t)(b * SEQ + qrow) * NQKV + head * 64;
            float qf[4][8]; float ss = 0.f;
#pragma unroll
            for (int d0 = 0; d0 < 4; ++d0) { const u32x4 v = *(const u32x4*)(qp + 8 * (2 * d0 + hi));
                qf[d0][0] = bf_lo(v.x); qf[d0][1] = bf_hi(v.x); qf[d0][2] = bf_lo(v.y); qf[d0][3] = bf_hi(v.y); qf[d0][4] = bf_lo(v.z); qf[d0][5] = bf_hi(v.z); qf[d0][6] = bf_lo(v.w); qf[d0][7] = bf_hi(v.w);
#pragma unroll
                for (int i = 0; i < 8; ++i) ss += qf[d0][i] * qf[d0][i]; }
            ss += __shfl_xor(ss, 32);
            const float rstd = rsqrtf(ss * (1.0f / 64.0f) + 1e-6f);
#pragma unroll
            for (int d0 = 0; d0 < 4; ++d0)
#pragma unroll
                for (int i = 0; i < 8; ++i) qf[d0][i] *= rstd * qgain[8 * (2 * d0 + hi) + i];
            const float* rp = ROPE + (size_t)qrow * 64;
            float qo[4][8];
#pragma unroll
            for (int d0 = 0; d0 < 2; ++d0)
#pragma unroll
                for (int i = 0; i < 8; ++i) { const int j = 8 * (2 * d0 + hi) + i; const float cs = rp[j], sn = rp[32 + j];
                    qo[d0][i] = qf[d0][i] * cs - qf[d0 + 2][i] * sn; qo[d0 + 2][i] = qf[d0][i] * sn + qf[d0 + 2][i] * cs; }
#pragma unroll
            for (int d0 = 0; d0 < 4; ++d0) { u32x4 pw; pw.x = pk2(qo[d0][0] * C2, qo[d0][1] * C2); pw.y = pk2(qo[d0][2] * C2, qo[d0][3] * C2); pw.z = pk2(qo[d0][4] * C2, qo[d0][5] * C2); pw.w = pk2(qo[d0][6] * C2, qo[d0][7] * C2);
                qr[d0] = __builtin_bit_cast(bf16x8, pw); }
        }
        float m_ref = sink[head] * 1.4426950408889634f; float l_run = hi ? 0.f : 1.f;
        f32x16 o0 = {}, o1 = {}; f32x16 negm;
#pragma unroll
        for (int r = 0; r < 16; ++r) negm[r] = -m_ref;
        u32x4 kreg, vreg, kreg2, vreg2, kreg3, vreg3;
#define TILE_K0(ti) (((ti) < 4) ? 64 * (ti) : q0 - 128 + 64 * (jlo + (ti) - 4))
#define LOAD_TILE(ti, kreg, vreg) do { const int k0_ = TILE_K0(ti); const size_t grow_ = ((ti) < 4) ? (size_t)(M_ + b * LCTX + k0_) : (size_t)(b * SEQ + k0_); \
        kreg = *(const u32x4*)(QKV + (grow_ + krow) * NQKV + 1024 + kvh * 64 + 8 * kch); vreg = *(const u32x4*)(QKV + (grow_ + lane) * NQKV + 1280 + kvh * 64 + 8 * w); } while (0)
#define STORE_TILE(buf, ti) do { *(LAS u32x4*)(L + (buf) * KBYTES + krow * KS + kch * 16) = kreg; \
        LAS unsigned short* vt_ = (LAS unsigned short*)(L + VOFF + (buf) * VBYTES + (8 * w) * VS + 2 * lane); \
        vt_[0 * (VS / 2)] = (unsigned short)(vreg.x & 0xffffu); vt_[1 * (VS / 2)] = (unsigned short)(vreg.x >> 16); vt_[2 * (VS / 2)] = (unsigned short)(vreg.y & 0xffffu); vt_[3 * (VS / 2)] = (unsigned short)(vreg.y >> 16); \
        vt_[4 * (VS / 2)] = (unsigned short)(vreg.z & 0xffffu); vt_[5 * (VS / 2)] = (unsigned short)(vreg.z >> 16); vt_[6 * (VS / 2)] = (unsigned short)(vreg.w & 0xffffu); vt_[7 * (VS / 2)] = (unsigned short)(vreg.w >> 16); } while (0)
        if (MODE & 1) { LOAD_TILE(0, kreg, vreg); STORE_TILE(0, 0); LOAD_TILE(1, kreg, vreg); LOAD_TILE(2, kreg2, vreg2); LOAD_TILE(3, kreg3, vreg3); } __syncthreads();
#pragma unroll 1
        for (int ti = 0; ti < ntiles; ++ti) {
            const int buf = ti & 1;
            if (MODE & 2) {
            f32x16 p0 = negm, p1 = negm;
            {
                const LAS unsigned char* kb = L + buf * KBYTES + r32 * KS + hi * 16;
#pragma unroll
                for (int d0 = 0; d0 < 4; ++d0) { const bf16x8 k0f = *(const LAS bf16x8*)(kb + d0 * 32); const bf16x8 k1f = *(const LAS bf16x8*)(kb + 32 * KS + d0 * 32);
                    p0 = __builtin_amdgcn_mfma_f32_32x32x16_bf16(k0f, qr[d0], p0, 0, 0, 0); p1 = __builtin_amdgcn_mfma_f32_32x32x16_bf16(k1f, qr[d0], p1, 0, 0, 0); }
            }
            if (ti >= 4 && (jlo + ti - 4 == 0 || jlo + ti - 4 == 4)) { const int k0 = TILE_K0(ti); const int dbase = qrow - k0 - 4 * hi;
#pragma unroll
                for (int r = 0; r < 16; ++r) { const int dq = dbase - ((r & 3) + 8 * (r >> 2)); if (dq > 128 || dq < -128) p0[r] = -INFINITY; const int dq1 = dq - 32; if (dq1 > 128 || dq1 < -128) p1[r] = -INFINITY; } }
            float mx = fmaxf(p0[0], p1[0]);
#pragma unroll
            for (int r = 1; r < 16; ++r) mx = fmaxf(mx, fmaxf(p0[r], p1[r]));
            mx = fmaxf(mx, __shfl_xor(mx, 32));
            if (__any(mx > 8.0f)) {
                const float dl = fmaxf(mx, 0.f); m_ref += dl; const float f = __builtin_amdgcn_exp2f(-dl); l_run *= f;
#pragma unroll
                for (int r = 0; r < 16; ++r) { p0[r] -= dl; p1[r] -= dl; o0[r] *= f; o1[r] *= f; negm[r] = -m_ref; }
            }
            float ls = 0.f;
#pragma unroll
            for (int r = 0; r < 16; ++r) { p0[r] = __builtin_amdgcn_exp2f(p0[r]); p1[r] = __builtin_amdgcn_exp2f(p1[r]); ls += p0[r] + p1[r]; }
            l_run += ls;
            bf16x8 pa[4];
            { u32x4 t0, t1, t2, t3;
              t0.x = pk2(p0[0], p0[1]); t0.y = pk2(p0[2], p0[3]); t0.z = pk2(p0[4], p0[5]); t0.w = pk2(p0[6], p0[7]);
              t1.x = pk2(p0[8], p0[9]); t1.y = pk2(p0[10], p0[11]); t1.z = pk2(p0[12], p0[13]); t1.w = pk2(p0[14], p0[15]);
              t2.x = pk2(p1[0], p1[1]); t2.y = pk2(p1[2], p1[3]); t2.z = pk2(p1[4], p1[5]); t2.w = pk2(p1[6], p1[7]);
              t3.x = pk2(p1[8], p1[9]); t3.y = pk2(p1[10], p1[11]); t3.z = pk2(p1[12], p1[13]); t3.w = pk2(p1[14], p1[15]);
              pa[0] = __builtin_bit_cast(bf16x8, t0); pa[1] = __builtin_bit_cast(bf16x8, t1); pa[2] = __builtin_bit_cast(bf16x8, t2); pa[3] = __builtin_bit_cast(bf16x8, t3); }
            {
                const LAS unsigned char* vb = L + VOFF + buf * VBYTES + r32 * VS + 8 * hi;
#pragma unroll
                for (int s = 0; s < 4; ++s) {
                    const s16x4 a0 = *(const LAS s16x4*)(vb + 32 * s), a1 = *(const LAS s16x4*)(vb + 32 * s + 16);
                    const s16x4 c0 = *(const LAS s16x4*)(vb + 32 * VS + 32 * s), c1 = *(const LAS s16x4*)(vb + 32 * VS + 32 * s + 16);
                    const bf16x8 va = (bf16x8){a0[0], a0[1], a0[2], a0[3], a1[0], a1[1], a1[2], a1[3]}, vc = (bf16x8){c0[0], c0[1], c0[2], c0[3], c1[0], c1[1], c1[2], c1[3]};
                    o0 = __builtin_amdgcn_mfma_f32_32x32x16_bf16(va, pa[s], o0, 0, 0, 0); o1 = __builtin_amdgcn_mfma_f32_32x32x16_bf16(vc, pa[s], o1, 0, 0, 0);
                }
            }
            }
            if (MODE & 1) { if (ti + 1 < ntiles) STORE_TILE(buf ^ 1, ti + 1);
            kreg = kreg2; vreg = vreg2; kreg2 = kreg3; vreg2 = vreg3;
            if (ti + 4 < ntiles) LOAD_TILE(ti + 4, kreg3, vreg3); }
            __syncthreads();
        }
#undef LOAD_TILE
#undef STORE_TILE
#undef TILE_K0
        if (MODE & 2) {
        const float lt = l_run + __shfl_xor(l_run, 32); const float inv = 1.0f / lt;
        bf16_t* op = OB + (size_t)(b * SEQ + qrow) * 1024 + head * 64 + 4 * hi;
#pragma unroll
        for (int g = 0; g < 4; ++g) {
            u32x2 w0, w1; w0.x = pk2(o0[4 * g] * inv, o0[4 * g + 1] * inv); w0.y = pk2(o0[4 * g + 2] * inv, o0[4 * g + 3] * inv);
            w1.x = pk2(o1[4 * g] * inv, o1[4 * g + 1] * inv); w1.y = pk2(o1[4 * g + 2] * inv, o1[4 * g + 3] * inv);
            *(u32x2*)(op + 8 * g) = w0; *(u32x2*)(op + 32 + 8 * g) = w1;
        }
        }
    }
}

template <int MODE = 3> __device__ __forceinline__ void attn_phase4(LAS unsigned char* L, const Args& a, int vcu, int G) {
    const int tid = threadIdx.x, lane = tid & 63, w = __builtin_amdgcn_readfirstlane(tid >> 6), r32 = lane & 31, hi = lane >> 5;
    constexpr int KS = 144, VS = 136, KBYTES = 64 * KS, VBYTES = 64 * VS, VOFF = 2 * KBYTES;
    const bf16_t* QKV = (const bf16_t*)(a.ws + WS_QKV); bf16_t* OB = (bf16_t*)(a.ws + WS_OB); const float* ROPE = (const float*)(a.ws + WS_ROPE);
    const float* qgain = a.in[10]; const float* sink = a.in[12];
    const float C2 = 0.125f * 1.4426950408889634f;
    const int krow = w * 8 + (lane >> 3), kch = lane & 7;
    u32x4 kreg, vreg, kreg2, vreg2, kreg3, vreg3;
#define LOAD_CTX(bq_, kvq_, tn_, kreg, vreg) do { const size_t grow_ = (size_t)(M_ + (bq_) * LCTX + 64 * (tn_)); \
        kreg = *(const u32x4*)(QKV + (grow_ + krow) * NQKV + 1024 + (kvq_) * 64 + 8 * kch); vreg = *(const u32x4*)(QKV + (grow_ + lane) * NQKV + 1280 + (kvq_) * 64 + 8 * w); } while (0)
    if (vcu < 4096) { const int b0_ = vcu >> 9, kv0_ = (vcu >> 7) & 3; LOAD_CTX(b0_, kv0_, 0, kreg, vreg); LOAD_CTX(b0_, kv0_, 1, kreg2, vreg2); LOAD_CTX(b0_, kv0_, 2, kreg3, vreg3); }
    u32x4 qraw[4]; f32x4 rcs[4], rsn[4];
#define Q_PREFETCH(u_) do { const int b_ = (u_) >> 9, kvh_ = ((u_) >> 7) & 3, q0_ = ((u_) & 127) * 64; const int head_ = kvh_ * 4 + (w & 3), qrow_ = q0_ + 32 * (w >> 2) + r32; \
        const bf16_t* qp_ = QKV + (size_t)(b_ * SEQ + qrow_) * NQKV + head_ * 64; const float* rp_ = ROPE + (size_t)qrow_ * 64; \
        _Pragma("unroll") for (int d0 = 0; d0 < 4; ++d0) qraw[d0] = *(const u32x4*)(qp_ + 8 * (2 * d0 + hi)); \
        _Pragma("unroll") for (int d0 = 0; d0 < 2; ++d0) { const int j_ = 8 * (2 * d0 + hi); rcs[2 * d0] = *(const f32x4*)(rp_ + j_); rcs[2 * d0 + 1] = *(const f32x4*)(rp_ + j_ + 4); \
            rsn[2 * d0] = *(const f32x4*)(rp_ + 32 + j_); rsn[2 * d0 + 1] = *(const f32x4*)(rp_ + 32 + j_ + 4); } } while (0)
    if (vcu < 4096) Q_PREFETCH(vcu);
    for (int unit = vcu; unit < 4096; unit += G) {
        const int b = unit >> 9, kvh = (unit >> 7) & 3, qb = unit & 127, q0 = qb * 64;
        const int head = kvh * 4 + (w & 3), qrow = q0 + 32 * (w >> 2) + r32;
        const int jlo = (q0 < 128) ? ((128 - q0) >> 6) : 0; const int jhi = (q0 > SEQ - 192) ? ((SEQ + 64 - q0) >> 6) : 4; const int ntiles = 4 + (jhi - jlo + 1);
        bf16x8 qr[4];
        {
            float qf[4][8]; float ss = 0.f;
#pragma unroll
            for (int d0 = 0; d0 < 4; ++d0) { const u32x4 v = qraw[d0];
                qf[d0][0] = bf_lo(v.x); qf[d0][1] = bf_hi(v.x); qf[d0][2] = bf_lo(v.y); qf[d0][3] = bf_hi(v.y); qf[d0][4] = bf_lo(v.z); qf[d0][5] = bf_hi(v.z); qf[d0][6] = bf_lo(v.w); qf[d0][7] = bf_hi(v.w);
#pragma unroll
                for (int i = 0; i < 8; ++i) ss += qf[d0][i] * qf[d0][i]; }
            ss += __shfl_xor(ss, 32);
            const float rstd = rsqrtf(ss * (1.0f / 64.0f) + 1e-6f);
#pragma unroll
            for (int d0 = 0; d0 < 4; ++d0) { const f32x4 g0 = *(const f32x4*)(qgain + 8 * (2 * d0 + hi)), g1 = *(const f32x4*)(qgain + 8 * (2 * d0 + hi) + 4);
#pragma unroll
                for (int i = 0; i < 4; ++i) { qf[d0][i] *= rstd * g0[i]; qf[d0][4 + i] *= rstd * g1[i]; } }
            float qo[4][8];
#pragma unroll
            for (int d0 = 0; d0 < 2; ++d0)
#pragma unroll
                for (int i = 0; i < 8; ++i) { const float cs = rcs[2 * d0 + (i >> 2)][i & 3], sn = rsn[2 * d0 + (i >> 2)][i & 3];
                    qo[d0][i] = qf[d0][i] * cs - qf[d0 + 2][i] * sn; qo[d0 + 2][i] = qf[d0][i] * sn + qf[d0 + 2][i] * cs; }
#pragma unroll
            for (int d0 = 0; d0 < 4; ++d0) { u32x4 pw; pw.x = pk2(qo[d0][0] * C2, qo[d0][1] * C2); pw.y = pk2(qo[d0][2] * C2, qo[d0][3] * C2); pw.z = pk2(qo[d0][4] * C2, qo[d0][5] * C2); pw.w = pk2(qo[d0][6] * C2, qo[d0][7] * C2);
                qr[d0] = __builtin_bit_cast(bf16x8, pw); }
        }
        if (unit + G < 4096) Q_PREFETCH(unit + G);
        float m_ref = sink[head] * 1.4426950408889634f; float l_run = hi ? 0.f : 1.f;
        f32x16 o0 = {}, o1 = {}; f32x16 negm;
#pragma unroll
        for (int r = 0; r < 16; ++r) negm[r] = -m_ref;
        const bool has_next = unit + G < 4096; const int bN = (unit + G) >> 9, kvN = ((unit + G) >> 7) & 3;
#define TILE_K0(ti) (((ti) < 4) ? 64 * (ti) : q0 - 128 + 64 * (jlo + (ti) - 4))
#define LOAD_TILE(ti, kreg, vreg) do { const int k0_ = TILE_K0(ti); const size_t grow_ = ((ti) < 4) ? (size_t)(M_ + b * LCTX + k0_) : (size_t)(b * SEQ + k0_); \
        kreg = *(const u32x4*)(QKV + (grow_ + krow) * NQKV + 1024 + kvh * 64 + 8 * kch); vreg = *(const u32x4*)(QKV + (grow_ + lane) * NQKV + 1280 + kvh * 64 + 8 * w); } while (0)
#define STORE_TILE(kbuf, vbuf) do { *(LAS u32x4*)(L + (kbuf) * KBYTES + krow * KS + kch * 16) = kreg; \
        LAS unsigned short* vt_ = (LAS unsigned short*)(L + VOFF + (vbuf) * VBYTES + (8 * w) * VS + 2 * lane); \
        vt_[0 * (VS / 2)] = (unsigned short)(vreg.x & 0xffffu); vt_[1 * (VS / 2)] = (unsigned short)(vreg.x >> 16); vt_[2 * (VS / 2)] = (unsigned short)(vreg.y & 0xffffu); vt_[3 * (VS / 2)] = (unsigned short)(vreg.y >> 16); \
        vt_[4 * (VS / 2)] = (unsigned short)(vreg.z & 0xffffu); vt_[5 * (VS / 2)] = (unsigned short)(vreg.z >> 16); vt_[6 * (VS / 2)] = (unsigned short)(vreg.w & 0xffffu); vt_[7 * (VS / 2)] = (unsigned short)(vreg.w >> 16); } while (0)
#define QK_MAX(ti, kbuf) \
        f32x16 p0 = negm, p1 = negm; \
        { const LAS unsigned char* kb_ = L + (kbuf) * KBYTES + r32 * KS + hi * 16; \
          _Pragma("unroll") for (int d0 = 0; d0 < 4; ++d0) { const bf16x8 k0f = *(const LAS bf16x8*)(kb_ + d0 * 32); const bf16x8 k1f = *(const LAS bf16x8*)(kb_ + 32 * KS + d0 * 32); \
            p0 = __builtin_amdgcn_mfma_f32_32x32x16_bf16(k0f, qr[d0], p0, 0, 0, 0); p1 = __builtin_amdgcn_mfma_f32_32x32x16_bf16(k1f, qr[d0], p1, 0, 0, 0); } } \
        if ((ti) >= 4 && (jlo + (ti) - 4 == 0 || jlo + (ti) - 4 == 4)) { const int k0_ = TILE_K0(ti); const int dbase = qrow - k0_ - 4 * hi; \
          _Pragma("unroll") for (int r = 0; r < 16; ++r) { const int dq = dbase - ((r & 3) + 8 * (r >> 2)); if (dq > 128 || dq < -128) p0[r] = -INFINITY; const int dq1 = dq - 32; if (dq1 > 128 || dq1 < -128) p1[r] = -INFINITY; } } \
        float mx = fmaxf(p0[0], p1[0]); \
        _Pragma("unroll") for (int r = 1; r < 16; ++r) mx = fmaxf(mx, fmaxf(p0[r], p1[r])); \
        mx = fmaxf(mx, __shfl_xor(mx, 32)); \
        const bool resc = __any(mx > 8.0f); float fres = 1.0f; \
        if (resc) { const float dl = fmaxf(mx, 0.f); m_ref += dl; fres = __builtin_amdgcn_exp2f(-dl); l_run *= fres; \
          _Pragma("unroll") for (int r = 0; r < 16; ++r) { p0[r] -= dl; p1[r] -= dl; negm[r] = -m_ref; } }
#define EXP_PACK() do { float ls = 0.f; \
        _Pragma("unroll") for (int r = 0; r < 16; ++r) { p0[r] = __builtin_amdgcn_exp2f(p0[r]); p1[r] = __builtin_amdgcn_exp2f(p1[r]); ls += p0[r] + p1[r]; } \
        l_run += ls; \
        { u32x4 t0, t1, t2, t3; \
          t0.x = pk2(p0[0], p0[1]); t0.y = pk2(p0[2], p0[3]); t0.z = pk2(p0[4], p0[5]); t0.w = pk2(p0[6], p0[7]); \
          t1.x = pk2(p0[8], p0[9]); t1.y = pk2(p0[10], p0[11]); t1.z = pk2(p0[12], p0[13]); t1.w = pk2(p0[14], p0[15]); \
          t2.x = pk2(p1[0], p1[1]); t2.y = pk2(p1[2], p1[3]); t2.z = pk2(p1[4], p1[5]); t2.w = pk2(p1[6], p1[7]); \
          t3.x = pk2(p1[8], p1[9]); t3.y = pk2(p1[10], p1[11]); t3.z = pk2(p1[12], p1[13]); t3.w = pk2(p1[14], p1[15]); \
          pa[0] = __builtin_bit_cast(bf16x8, t0); pa[1] = __builtin_bit_cast(bf16x8, t1); pa[2] = __builtin_bit_cast(bf16x8, t2); pa[3] = __builtin_bit_cast(bf16x8, t3); } } while (0)
#define PV_TILE(vbuf) do { const LAS unsigned char* vb_ = L + VOFF + (vbuf) * VBYTES + r32 * VS + 8 * hi; \
        _Pragma("unroll") for (int s = 0; s < 4; ++s) { \
            const s16x4 a0 = *(const LAS s16x4*)(vb_ + 32 * s), a1 = *(const LAS s16x4*)(vb_ + 32 * s + 16); \
            const s16x4 c0 = *(const LAS s16x4*)(vb_ + 32 * VS + 32 * s), c1 = *(const LAS s16x4*)(vb_ + 32 * VS + 32 * s + 16); \
            const bf16x8 va = (bf16x8){a0[0], a0[1], a0[2], a0[3], a1[0], a1[1], a1[2], a1[3]}, vc = (bf16x8){c0[0], c0[1], c0[2], c0[3], c1[0], c1[1], c1[2], c1[3]}; \
            o0 = __builtin_amdgcn_mfma_f32_32x32x16_bf16(va, pa[s], o0, 0, 0, 0); o1 = __builtin_amdgcn_mfma_f32_32x32x16_bf16(vc, pa[s], o1, 0, 0, 0); } } while (0)
#define STAGE_NEXT(ti, vnext) do { if ((ti) + 1 < ntiles) { STORE_TILE(((ti) + 1) & 1, vnext); \
        kreg = kreg2; vreg = vreg2; kreg2 = kreg3; vreg2 = vreg3; \
        if ((ti) + 4 < ntiles) LOAD_TILE((ti) + 4, kreg3, vreg3); else if (has_next) LOAD_CTX(bN, kvN, (ti) + 4 - ntiles, kreg3, vreg3); } } while (0)
        bf16x8 pa[4];
        STORE_TILE(0, 0); kreg = kreg2; vreg = vreg2; kreg2 = kreg3; vreg2 = vreg3; LOAD_TILE(3, kreg3, vreg3); __syncthreads();
        {
            QK_MAX(0, 0)
            EXP_PACK();
            if (resc) { _Pragma("unroll") for (int r = 0; r < 16; ++r) { o0[r] *= fres; o1[r] *= fres; } }
            STAGE_NEXT(0, 1);
            __syncthreads();
        }
        int vprev = 0, vcur = 1;
#pragma unroll 1
        for (int ti = 1; ti < ntiles; ++ti) {
            const int vnext = (vcur == 2) ? 0 : vcur + 1;
            QK_MAX(ti, ti & 1)
            PV_TILE(vprev);
            EXP_PACK();
#pragma unroll
            for (int i_ = 0; i_ < 8; ++i_) { __builtin_amdgcn_sched_group_barrier(0x008, 1, 0); __builtin_amdgcn_sched_group_barrier(0x002, 11, 0); }
            if (resc) { _Pragma("unroll") for (int r = 0; r < 16; ++r) { o0[r] *= fres; o1[r] *= fres; } }
            STAGE_NEXT(ti, vnext);
            vprev = vcur; vcur = vnext;
            __syncthreads();
        }
        PV_TILE(vprev);
        __syncthreads();
#undef LOAD_TILE
#undef STORE_TILE
#undef TILE_K0
#undef QK_MAX
#undef EXP_PACK
#undef PV_TILE
#undef STAGE_NEXT
#undef Q_PREFETCH
#undef LOAD_CTX
        if (MODE & 2) {
        const float lt = l_run + __shfl_xor(l_run, 32); const float inv = 1.0f / lt;
        bf16_t* op = OB + (size_t)(b * SEQ + qrow) * 1024 + head * 64 + 4 * hi;
#pragma unroll
        for (int g = 0; g < 4; ++g) {
            u32x2 w0, w1; w0.x = pk2(o0[4 * g] * inv, o0[4 * g + 1] * inv); w0.y = pk2(o0[4 * g + 2] * inv, o0[4 * g + 3] * inv);
            w1.x = pk2(o1[4 * g] * inv, o1[4 * g + 1] * inv); w1.y = pk2(o1[4 * g + 2] * inv, o1[4 * g + 3] * inv);
            *(u32x2*)(op + 8 * g) = w0; *(u32x2*)(op + 32 + 8 * g) = w1;
        }
        }
    }
}

__device__ __forceinline__ void conv3(const unsigned* zp, int dw, float w0, float w1, float w2, float cb, float& o0, float& o1) {
    const unsigned cur = zp[dw]; const unsigned prev = dw > 0 ? zp[dw - 1] : 0u; const unsigned next = dw < SEQ / 2 - 1 ? zp[dw + 1] : 0u;
    const float zm1 = bf_hi(prev), z0 = bf_lo(cur), z1 = bf_hi(cur), z2 = bf_lo(next);
    o0 = w0 * zm1 + w1 * z0 + w2 * z1 + cb; o1 = w0 * z0 + w1 * z1 + w2 * z2 + cb;
}
__device__ __forceinline__ void conv8(const unsigned* zp, int cidx, float w0, float w1, float w2, float cb, float (&o)[8]) {
    const u32x4 cur = *(const u32x4*)(zp + 4 * cidx); const unsigned prev = cidx > 0 ? zp[4 * cidx - 1] : 0u; const unsigned next = cidx < SEQ / 8 - 1 ? zp[4 * cidx + 4] : 0u;
    const float zz[10] = {bf_hi(prev), bf_lo(cur.x), bf_hi(cur.x), bf_lo(cur.y), bf_hi(cur.y), bf_lo(cur.z), bf_hi(cur.z), bf_lo(cur.w), bf_hi(cur.w), bf_lo(next)};
#pragma unroll
    for (int e = 0; e < 8; ++e) o[e] = w0 * zz[e] + w1 * zz[e + 1] + w2 * zz[e + 2] + cb;
}
struct Raw8 { u32x4 cur; unsigned prev, next; };
__device__ __forceinline__ Raw8 raw8_load(const unsigned* zp, int cidx) { Raw8 r; r.cur = *(const u32x4*)(zp + 4 * cidx); r.prev = cidx > 0 ? zp[4 * cidx - 1] : 0u; r.next = cidx < SEQ / 8 - 1 ? zp[4 * cidx + 4] : 0u; return r; }
__device__ __forceinline__ void conv8_raw(const Raw8& r, float w0, float w1, float w2, float cb, float (&o)[8]) {
    const float zz[10] = {bf_hi(r.prev), bf_lo(r.cur.x), bf_hi(r.cur.x), bf_lo(r.cur.y), bf_hi(r.cur.y), bf_lo(r.cur.z), bf_hi(r.cur.z), bf_lo(r.cur.w), bf_hi(r.cur.w), bf_lo(r.next)};
#pragma unroll
    for (int e = 0; e < 8; ++e) o[e] = w0 * zz[e] + w1 * zz[e + 1] + w2 * zz[e + 2] + cb;
}
__device__ __forceinline__ void hyena_phase(LAS unsigned char* L, const Args& a, int vcu, int G) {
    const int tid = threadIdx.x;
    LAS cf* z = (LAS cf*)L; LAS cf* Thi = (LAS cf*)(L + 131072); LAS cf* Tlo = Thi + 128;
    const bf16_t* ZT = (const bf16_t*)(a.ws + WS_ZT); bf16_t* Gc = (bf16_t*)(a.ws + WS_G);
    const f32x4* SD = (const f32x4*)(a.ws + WS_SD); const f32x4* SD8 = (const f32x4*)(a.ws + WS_SD8);
    const float* cw = a.in[15]; const float* cb = a.in[16]; const float* skip = a.in[25];
    fft_tables(Thi, Tlo, tid);
    Raw8 nx1a[2], nx1b[2], nxva[2], nxvb[2];
#define HY_PREFETCH(u_) do { const int b_ = (u_) & 7, ca_ = 2 * ((u_) >> 3); \
        const unsigned* q1a = (const unsigned*)(ZT + (size_t)(D_ + ca_) * ZLD + (size_t)b_ * SEQ); const unsigned* q1b = (const unsigned*)(ZT + (size_t)(D_ + ca_ + 1) * ZLD + (size_t)b_ * SEQ); \
        const unsigned* qva = (const unsigned*)(ZT + (size_t)(2 * D_ + ca_) * ZLD + (size_t)b_ * SEQ); const unsigned* qvb = (const unsigned*)(ZT + (size_t)(2 * D_ + ca_ + 1) * ZLD + (size_t)b_ * SEQ); \
        _Pragma("unroll") for (int i = 0; i < 2; ++i) { const int cidx = tid + 512 * i; nx1a[i] = raw8_load(q1a, cidx); nx1b[i] = raw8_load(q1b, cidx); nxva[i] = raw8_load(qva, cidx); nxvb[i] = raw8_load(qvb, cidx); } } while (0)
    if (vcu < 4096) HY_PREFETCH(vcu);
    for (int unit = vcu; unit < 4096; unit += G) {
        const int b = unit & 7, pair = unit >> 3, ca = 2 * pair;
        float ua[2][8], ub[2][8];
        {
            const int r1a = D_ + ca, r1b = r1a + 1, rva = 2 * D_ + ca, rvb = rva + 1;
            const float w1a0 = cw[r1a], w1a1 = cw[3072 + r1a], w1a2 = cw[6144 + r1a], c1a = cb[r1a];
            const float w1b0 = cw[r1b], w1b1 = cw[3072 + r1b], w1b2 = cw[6144 + r1b], c1b = cb[r1b];
            const float wva0 = cw[rva], wva1 = cw[3072 + rva], wva2 = cw[6144 + rva], cva = cb[rva];
            const float wvb0 = cw[rvb], wvb1 = cw[3072 + rvb], wvb2 = cw[6144 + rvb], cvb = cb[rvb];
#pragma unroll
            for (int i = 0; i < 2; ++i) { const int cidx = tid + 512 * i;
                float x1[8], vv[8];
                conv8_raw(nx1a[i], w1a0, w1a1, w1a2, c1a, x1); conv8_raw(nxva[i], wva0, wva1, wva2, cva, vv);
#pragma unroll
                for (int e = 0; e < 8; ++e) ua[i][e] = vv[e] * x1[e];
                conv8_raw(nx1b[i], w1b0, w1b1, w1b2, c1b, x1); conv8_raw(nxvb[i], wvb0, wvb1, wvb2, cvb, vv);
#pragma unroll
                for (int e = 0; e < 8; ++e) ub[i][e] = vv[e] * x1[e];
#pragma unroll
                for (int e = 0; e < 8; e += 2) *(LAS f32x4*)(z + PH(8 * cidx + e)) = (f32x4){ua[i][e], ub[i][e], ua[i][e + 1], ub[i][e + 1]};
            }
        }
        __syncthreads();
        fft_pass16<false, 10, true>(z, Thi, Tlo, tid); fft_pass16<false, 6>(z, Thi, Tlo, tid); fft_pass16<false, 2>(z, Thi, Tlo, tid);
        f32x4 sd[16];
        {
            const f32x4* sdp = SD + (size_t)pair * 8192;
#pragma unroll
            for (int i = 0; i < 16; ++i) sd[i] = sdp[2 * (tid + 512 * (i >> 1)) + (i & 1)];
        }
        fft_pass4<false>(z, tid);
        {
#pragma unroll
            for (int i = 0; i < 8; ++i) {
                const int g = tid + 512 * i;
                const int kg = (g >> 8) | (((g >> 4) & 15) << 4) | ((g & 15) << 8);
                const int pp0 = p_of_k((NFFT - kg) & (NFFT - 1)), pp1 = p_of_k(12288 - kg);
                const int p0 = PH(4 * g);
                const f32x4 zz = *(LAS f32x4*)(z + p0);
                const cf zk0 = {zz[0], zz[1]}, zk1 = {zz[2], zz[3]};
                const cf zn0 = z[PH(pp0)], zn1 = z[PH(pp1)];
                const f32x4 s0 = sd[2 * i], s1 = sd[2 * i + 1];
                const cf S0 = {s0[0], s0[1]}, D0 = {s0[2], s0[3]}, S1 = {s1[0], s1[1]}, D1 = {s1[2], s1[3]};
                const cf w0 = cmul(zk0, S0) + cmul(cconj(zn0), D0), w1 = cmul(zk1, S1) + cmul(cconj(zn1), D1);
                *(LAS f32x4*)(z + p0) = (f32x4){w0.x, w0.y, w1.x, w1.y};
                if (kg != 0) z[PH(pp0)] = cmulc(zn0, S0) + cconj(cmul(zk0, D0));
                z[PH(pp1)] = cmulc(zn1, S1) + cconj(cmul(zk1, D1));
            }
            if (tid == 0) { const f32x4 s8 = SD8[pair]; const cf S = {s8[0], s8[1]}, Dd = {s8[2], s8[3]}; const cf zk = z[PH(2)]; z[PH(2)] = cmul(zk, S) + cmul(cconj(zk), Dd); }
        }
        __syncthreads();
        fft_pass4<true>(z, tid); fft_pass16<true, 2>(z, Thi, Tlo, tid); fft_pass16<true, 6>(z, Thi, Tlo, tid);
        float xa[2][8], xb[2][8];
        {
            const int r0a = ca, r0b = ca + 1;
            const float wa0 = cw[r0a], wa1 = cw[3072 + r0a], wa2 = cw[6144 + r0a], c0a = cb[r0a];
            const float wb0 = cw[r0b], wb1 = cw[3072 + r0b], wb2 = cw[6144 + r0b], c0b = cb[r0b];
            const unsigned* p0a = (const unsigned*)(ZT + (size_t)r0a * ZLD + (size_t)b * SEQ); const unsigned* p0b = (const unsigned*)(ZT + (size_t)r0b * ZLD + (size_t)b * SEQ);
#pragma unroll
            for (int i = 0; i < 2; ++i) { const int cidx = tid + 512 * i; conv8(p0a, cidx, wa0, wa1, wa2, c0a, xa[i]); conv8(p0b, cidx, wb0, wb1, wb2, c0b, xb[i]); }
        }
        if (unit + G < 4096) HY_PREFETCH(unit + G);
        fft_pass16<true, 10, true>(z, Thi, Tlo, tid);
        {
            const float ska = skip[ca], skb = skip[ca + 1];
            u32x4* ga = (u32x4*)(Gc + (size_t)ca * GLD + (size_t)b * SEQ); u32x4* gb = (u32x4*)(Gc + (size_t)(ca + 1) * GLD + (size_t)b * SEQ);
#pragma unroll
            for (int i = 0; i < 2; ++i) { const int cidx = tid + 512 * i;
                float ya[8], yb[8];
#pragma unroll
                for (int e = 0; e < 8; e += 2) { const f32x4 y = *(LAS f32x4*)(z + PH(8 * cidx + e)); ya[e] = y[0]; yb[e] = y[1]; ya[e + 1] = y[2]; yb[e + 1] = y[3]; }
                u32x4 oa, ob;
                oa.x = pk2((ya[0] + ua[i][0] * ska) * xa[i][0], (ya[1] + ua[i][1] * ska) * xa[i][1]); oa.y = pk2((ya[2] + ua[i][2] * ska) * xa[i][2], (ya[3] + ua[i][3] * ska) * xa[i][3]);
                oa.z = pk2((ya[4] + ua[i][4] * ska) * xa[i][4], (ya[5] + ua[i][5] * ska) * xa[i][5]); oa.w = pk2((ya[6] + ua[i][6] * ska) * xa[i][6], (ya[7] + ua[i][7] * ska) * xa[i][7]);
                ob.x = pk2((yb[0] + ub[i][0] * skb) * xb[i][0], (yb[1] + ub[i][1] * skb) * xb[i][1]); ob.y = pk2((yb[2] + ub[i][2] * skb) * xb[i][2], (yb[3] + ub[i][3] * skb) * xb[i][3]);
                ob.z = pk2((yb[4] + ub[i][4] * skb) * xb[i][4], (yb[5] + ub[i][5] * skb) * xb[i][5]); ob.w = pk2((yb[6] + ub[i][6] * skb) * xb[i][6], (yb[7] + ub[i][7] * skb) * xb[i][7]);
                ga[cidx] = oa; gb[cidx] = ob; }
        }
        __syncthreads();
    }
}

#undef HY_PREFETCH
__device__ __forceinline__ void transpose_phase(LAS unsigned char* L, const Args& a) {
    const int tid = threadIdx.x, lane = tid & 63, w = tid >> 6; const int gw = blockIdx.x * 8 + w, NGW = gridDim.x * 8;
    const bf16_t* Gc = (const bf16_t*)(a.ws + WS_G); bf16_t* GT = (bf16_t*)(a.ws + WS_GT);
    LAS unsigned char* T = L + w * 16384;
    u32x4 nx[8];
#define TP_LOAD(item_) do { const int c0_ = ((item_) & 15) * 64, t0_ = ((item_) >> 4) * 64; \
        _Pragma("unroll") for (int j = 0; j < 8; ++j) nx[j] = *(const u32x4*)(Gc + (size_t)(c0_ + 8 * j + (lane >> 3)) * GLD + t0_ + 8 * (lane & 7)); } while (0)
    if (gw < 16 * 1024) TP_LOAD(gw);
    for (int item = gw; item < 16 * 1024; item += NGW) {
        const int cblk = item & 15, tblk = item >> 4; const int c0 = cblk * 64, t0 = tblk * 64;
#pragma unroll
        for (int j = 0; j < 8; ++j) { const int c = 8 * j + (lane >> 3), ch = lane & 7; const u32x4 v = nx[j];
            LAS unsigned* d = (LAS unsigned*)(T + c * 132 + ch * 16); d[0] = v.x; d[1] = v.y; d[2] = v.z; d[3] = v.w; }
        if (item + NGW < 16 * 1024) TP_LOAD(item + NGW);
        asm volatile("s_waitcnt lgkmcnt(0)" ::: "memory");
#pragma unroll
        for (int j = 0; j < 8; ++j) { const int t = 8 * j + (lane >> 3), ch = lane & 7; const LAS unsigned short* s = (const LAS unsigned short*)(T + (8 * ch) * 132 + 2 * t);
            u32x4 o; o.x = (unsigned)s[0] | ((unsigned)s[66] << 16); o.y = (unsigned)s[132] | ((unsigned)s[198] << 16); o.z = (unsigned)s[264] | ((unsigned)s[330] << 16); o.w = (unsigned)s[396] | ((unsigned)s[462] << 16);
            *(u32x4*)(GT + (size_t)(t0 + t) * 1024 + c0 + 8 * ch) = o; }
        asm volatile("s_waitcnt lgkmcnt(0)" ::: "memory");
    }
#undef TP_LOAD
}

#define XB_TMO      128
#define XB_XCNT(j)  (256  + 64 * (j))
#define XB_XSUB(j)  (1280 + 64 * (j))
#define XB_XGEN(j)  (2304 + 64 * (j))
#define XB_TOP      3328
#define XB_TOPGEN   3392
#define XCD_BAR_WORDS 3456
#define XB_SPIN_CAP (1u << 18)

__device__ __forceinline__ unsigned xb_ld(unsigned* p)              { return __hip_atomic_load(p, __ATOMIC_RELAXED, __HIP_MEMORY_SCOPE_AGENT); }
__device__ __forceinline__ unsigned xb_add(unsigned* p, unsigned v) { return __hip_atomic_fetch_add(p, v, __ATOMIC_RELAXED, __HIP_MEMORY_SCOPE_AGENT); }
__device__ __forceinline__ unsigned xb_xcc_id() { return (unsigned)__builtin_amdgcn_s_getreg((3 << 11) | 20) & 0xFu; }
#define XB_SPIN(cond, bar) do { unsigned _sp = 0; while (cond) { __builtin_amdgcn_s_sleep(1); \
    if ((++_sp & 255u) == 0u) { if (xb_ld(&(bar)[XB_TMO])) break; if (_sp > XB_SPIN_CAP) { atomicAdd(&(bar)[XB_TMO], 1u); break; } } } } while (0)

struct XcdBarrier {
    unsigned* bar; unsigned x;
    volatile LAS unsigned* st;
};

__device__ __forceinline__ XcdBarrier xcd_barrier_post(unsigned* bar, volatile LAS unsigned* st) {
    XcdBarrier b; b.bar = bar; b.x = xb_xcc_id(); b.st = st;
    if (threadIdx.x == 0) (void)xb_add(&bar[XB_XCNT(b.x)], 1u);
    return b;
}
__device__ __forceinline__ void xcd_barrier_complete(unsigned* bar, unsigned x, unsigned& nloc, unsigned& nx) {
    const unsigned G = gridDim.x * gridDim.y * gridDim.z;
    unsigned sum, cnt, mine, sp = 0u;
    for (;;) {
        sum = 0u; cnt = 0u; mine = 0u;
#pragma unroll
        for (unsigned j = 0; j < 16; ++j) { const unsigned c = xb_ld(&bar[XB_XCNT(j)]); sum += c; cnt += (c > 0u) ? 1u : 0u; mine = (j == x) ? c : mine; }
        if (sum == G) break;
        __builtin_amdgcn_s_sleep(1);
        if ((++sp & 255u) == 0u) { if (xb_ld(&bar[XB_TMO])) break; if (sp > XB_SPIN_CAP) { atomicAdd(&bar[XB_TMO], 1u); break; } }
    }
    nloc = mine > 0u ? mine : 1u; nx = cnt > 0u ? cnt : 1u;
}

__device__ __forceinline__ void xcd_barrier(const XcdBarrier& b) {
    asm volatile("s_waitcnt vmcnt(0)" ::: "memory");
    __syncthreads();
    if (threadIdx.x == 0) {
        unsigned* bar = b.bar;
        __builtin_amdgcn_s_waitcnt(0);
        unsigned nloc = b.st[0], nx = b.st[1];
        if (nloc == 0u) { xcd_barrier_complete(bar, b.x, nloc, nx); b.st[0] = nloc; b.st[1] = nx; }
        const unsigned old = xb_add(&bar[XB_XSUB(b.x)], 1u);
        const unsigned gen = old / nloc;
        if (old + 1u == (gen + 1u) * nloc) {
            __builtin_amdgcn_fence(__ATOMIC_RELEASE, "agent");
            asm volatile("s_waitcnt vmcnt(0)" ::: "memory");
            const unsigned og = xb_add(&bar[XB_TOP], 1u);
            const unsigned tg = og / nx;
            if (og + 1u == (tg + 1u) * nx) xb_add(&bar[XB_TOPGEN], 1u);
            else XB_SPIN(xb_ld(&bar[XB_TOPGEN]) == tg, bar);
            __builtin_amdgcn_fence(__ATOMIC_ACQUIRE, "agent");
            xb_add(&bar[XB_XGEN(b.x)], 1u);
            asm volatile("s_waitcnt vmcnt(0)" ::: "memory");
        } else {
            XB_SPIN(xb_ld(&bar[XB_XGEN(b.x)]) == gen, bar);
            __builtin_amdgcn_fence(__ATOMIC_ACQUIRE, "agent");
            asm volatile("s_waitcnt vmcnt(0)" ::: "memory");
        }
    }
    __syncthreads();
}

struct OneGroupOrder : pg8::StaticOrder {
    __device__ bool next(int i, pg8::Unit& u) const {
        const long Lq = (long)i * G + c; if (Lq >= nwg) return false;
        int wgid = (int)Lq; { const int q = nwg / pg8::NXCD, r = nwg % pg8::NXCD, xcd = wgid % pg8::NXCD, off = wgid / pg8::NXCD; wgid = (xcd < r ? xcd * (q + 1) : r * (q + 1) + (xcd - r) * q) + off; }
        u.pm = wgid % nM; u.pn = wgid / nM; return true;
    }
};
__global__ void __launch_bounds__(512, 2) fwd_megakernel(Args a) {
    extern __shared__ __attribute__((aligned(16))) unsigned char lds_raw[];
    LAS unsigned char* L = (LAS unsigned char*)lds_raw;
    const int G = gridDim.x, bx = blockIdx.x; const int vcu = (G % 8 == 0) ? (bx % 8) * (G / 8) + bx / 8 : bx;
    unsigned char* ws = a.ws;
    const float* MOD0 = (const float*)(ws + WS_MOD); const float* MOD1 = MOD0 + 9 * 6144;
    bf16_t* XN = (bf16_t*)(ws + WS_XN);
    const int lo = a.ph_lo, hi = a.ph_hi;
    volatile LAS unsigned* xst = (volatile LAS unsigned*)(L + LDS_BYTES - 64);
    if (threadIdx.x < 16) xst[threadIdx.x] = 0u;
    __syncthreads();
    XcdBarrier xbar; xbar.bar = (unsigned*)(ws + WS_BAR); xbar.x = 0; xbar.st = nullptr;
    if (hi - lo > 1) xbar = xcd_barrier_post((unsigned*)(ws + WS_BAR), xst);
#ifndef PHMASK
#define PHMASK 0x1ffff
#endif
#define IN(k) ((((PHMASK) >> (k)) & 1) && lo <= (k) && (k) < hi)
#define SEAM(k) do { if (IN(k) && IN((k) + 1)) { if ((k) == 0) cg::this_grid().sync(); else xcd_barrier(xbar); } } while (0)
#ifndef REPMASK
#define REPMASK 0
#endif
#define REP(k) for (int rep_ = 0; rep_ < ((((REPMASK) >> (k)) & 1) ? 2 : 1); ++rep_, (((REPMASK) >> (k)) & 1) ? cg::this_grid().sync() : (void)0)
#ifdef SYNC_PROBE
    if (lo == 0 && hi == NPHASE) { for (int q_ = 0; q_ < SYNC_PROBE; ++q_) cg::this_grid().sync(); }
#endif
#ifndef P0_PROBE
#define P0_PROBE 15
#endif
    if (IN(0)) REP(0) { if (rep_ == 0 && (REPMASK & 1)) phase0<P0_PROBE>(L, a); else phase0<15>(L, a); } SEAM(0);
#ifndef P1_PROBE
#define P1_PROBE 3
#endif
    if (IN(1)) REP(1) { const int sub_ = (rep_ == 0 && (REPMASK & 2)) ? P1_PROBE : 3; if (sub_ & 1) filter_phase(L, a); if (sub_ & 2) norm_phase(a, a.in[0], 0, 0, true); } SEAM(1);
    if (IN(2)) REP(2) { pg8::Gemm g{XN, (const bf16_t*)(ws + WS_WQKV), MT_, NQKV, 1024}; pg8::StaticOrder S; S.init(MT_, NQKV, G, bx);
        pg8::EpiStoreBf16 E{(bf16_t*)(ws + WS_QKV), (size_t)NQKV, nullptr}; pg8::gemm_phase<pg8::EpiStoreBf16, pg8::StaticOrder, true, true>(L, g, S, E); } SEAM(2);
    if (IN(3)) REP(3) { kprep_phase(a); } SEAM(3);
#ifndef ATTN_PROBE
#define ATTN_PROBE 3
#endif
    if (IN(4)) REP(4) { attn_phase4<3>(L, a, vcu, G); } SEAM(4);
    if (IN(5)) REP(5) { pg8::Gemm g{(const bf16_t*)(ws + WS_OB), (const bf16_t*)(ws + WS_WO), M_, 1024, 1024}; pg8::StaticOrder S; S.init(M_, 1024, G, bx);
        pg8::EpiResid<false, true> E{a.in[0], ws + WS_XS, MOD0 + 2 * 1024, nullptr}; pg8::gemm_phase<pg8::EpiResid<false, true>, pg8::StaticOrder, true, true>(L, g, S, E); } SEAM(5);
    if (IN(6)) REP(6) { norm_phase_bf16(a, 0, 1); } SEAM(6);
    if (IN(7)) REP(7) { pg8::Gemm g{XN, (const bf16_t*)(ws + WS_WFF1), M_, NFF1, 1024}; pg8::StaticOrder S; S.init(M_, NFF1, G, bx);
        pg8::EpiSwiGLU E{(bf16_t*)(ws + WS_H), DFF}; pg8::gemm_phase<pg8::EpiSwiGLU, pg8::StaticOrder, true, true>(L, g, S, E); } SEAM(7);
    if (IN(8)) REP(8) { pg8::Gemm g{(const bf16_t*)(ws + WS_H), (const bf16_t*)(ws + WS_WFF2), M_, 1024, DFF}; pg8::StaticOrder S; S.init(M_, 1024, G, bx);
        pg8::EpiResid<true, true> E{ws + WS_XS, ws + WS_XS, MOD0 + 5 * 1024, nullptr}; pg8::gemm_phase<pg8::EpiResid<true, true>, pg8::StaticOrder, true, true>(L, g, S, E); } SEAM(8);
    if (IN(9)) REP(9) { norm_phase_bf16(a, 1, 0); } SEAM(9);
    if (IN(10)) REP(10) { pg8::Gemm g{(const bf16_t*)(ws + WS_WIN), XN, 3072, M_, 1024}; OneGroupOrder S; S.init(3072, M_, G, bx);
        pg8::EpiStoreBf16 E{(bf16_t*)(ws + WS_ZT), ZLD, a.in[14]}; pg8::gemm_phase<pg8::EpiStoreBf16, OneGroupOrder, true, true>(L, g, S, E); } SEAM(10);
    if (IN(11)) REP(11) { hyena_phase(L, a, vcu, G); } SEAM(11);
    if (IN(12)) REP(12) { transpose_phase(L, a); } SEAM(12);
    if (IN(13)) REP(13) { pg8::Gemm g{(const bf16_t*)(ws + WS_GT), (const bf16_t*)(ws + WS_WOUT), M_, 1024, 1024}; pg8::StaticOrder S; S.init(M_, 1024, G, bx);
        pg8::EpiResid<true, true> E{ws + WS_XS, ws + WS_XS, MOD1 + 2 * 1024, a.in[27]}; pg8::gemm_phase<pg8::EpiResid<true, true>, pg8::StaticOrder, true, true>(L, g, S, E); } SEAM(13);
    if (IN(14)) REP(14) { norm_phase_bf16(a, 1, 1); } SEAM(14);
    if (IN(15)) REP(15) { pg8::Gemm g{XN, (const bf16_t*)(ws + WS_WFF1 + 11 * MiB), M_, NFF1, 1024}; pg8::StaticOrder S; S.init(M_, NFF1, G, bx);
        pg8::EpiSwiGLU E{(bf16_t*)(ws + WS_H), DFF}; pg8::gemm_phase<pg8::EpiSwiGLU, pg8::StaticOrder, true, true>(L, g, S, E); } SEAM(15);
    if (IN(16)) REP(16) { pg8::Gemm g{(const bf16_t*)(ws + WS_H), (const bf16_t*)(ws + WS_WFF2 + 6 * MiB), M_, 1024, DFF}; pg8::StaticOrder S; S.init(M_, 1024, G, bx);
        pg8::EpiResid<true, false> E{ws + WS_XS, a.out, MOD1 + 5 * 1024, nullptr}; pg8::gemm_phase<pg8::EpiResid<true, false>, pg8::StaticOrder, true, true>(L, g, S, E); }
#undef IN
#undef SEAM
}

#ifndef MK_MULTI
#define MK_MULTI 0
#endif
extern "C" void kernel_launch(void* const* d_in, const int* in_sizes, int n_in, void* d_out, int out_size, void* d_ws, size_t ws_size, hipStream_t stream) {
    static int grid = 0;
    if (grid == 0) {
        if (n_in != 31 || out_size != M_ * D_ || ws_size < WS_END) { fprintf(stderr, "kernel_launch: unexpected shapes n_in %d out %d ws %zu\n", n_in, out_size, ws_size); grid = -1; return; }
        int dev = 0, cus = 0, per_cu = 0;
        hipGetDevice(&dev); hipDeviceGetAttribute(&cus, hipDeviceAttributeMultiprocessorCount, dev);
        hipFuncSetAttribute((const void*)fwd_megakernel, hipFuncAttributeMaxDynamicSharedMemorySize, LDS_BYTES);
        hipOccupancyMaxActiveBlocksPerMultiprocessor(&per_cu, (const void*)fwd_megakernel, 512, LDS_BYTES);
        if (per_cu < 1) { fprintf(stderr, "kernel_launch: occupancy query says %d blocks per CU\n", per_cu); per_cu = 1; }
        (void)hipGetLastError();
        grid = cus * 1;
    }
    if (grid < 0) return;
    Args a{};
    for (int i = 0; i < 31; ++i) a.in[i] = (const float*)d_in[i];
    a.out = (float*)d_out; a.ws = (unsigned char*)d_ws;
    (void)hipMemsetAsync((unsigned char*)d_ws + WS_BAR, 0, 16384, stream);
#if MK_MULTI
    for (int ph = 0; ph < NPHASE; ++ph) { a.ph_lo = ph; a.ph_hi = ph + 1; hipLaunchKernelGGL(fwd_megakernel, dim3(grid), dim3(512), LDS_BYTES, stream, a); }
#else
    a.ph_lo = 0; a.ph_hi = NPHASE;
    void* args[] = {&a};
    hipError_t e = hipLaunchCooperativeKernel((const void*)fwd_megakernel, dim3(grid), dim3(512), args, LDS_BYTES, stream);
    if (e != hipSuccess) fprintf(stderr, "cooperative launch failed: %s (grid %d)\n", hipGetErrorString(e), grid);
#endif
}
```

```cpp
#include <hip/hip_runtime.h>
#include <hip/hip_cooperative_groups.h>
#include <cstdio>
#include <cstdint>
#include <cmath>
namespace cg = cooperative_groups;
namespace pg8 {
#define PG8_LAS __attribute__((address_space(3)))
typedef unsigned short bf16_t;
typedef short bf16x8 __attribute__((ext_vector_type(8)));
typedef float f32x4 __attribute__((ext_vector_type(4)));
typedef unsigned u32x4 __attribute__((ext_vector_type(4)));
constexpr int BM = 256, BK = 64, HALF = 128, HTB = HALF * BK * 2  , STAGE_BYTES = 8 * HTB, NXCD = 8, WGM = 8;

__host__ __device__ __forceinline__ int lds_byte(int r, int c) { const int st = (r >> 4) * 2 + (c >> 5), rr = r & 15, cc = c & 31, ob = rr * 64 + cc * 2; return st * 1024 + (ob ^ (((ob >> 9) & 1) << 5)); }
__host__ __device__ __forceinline__ void stage_rc(int b, int& R, int& C) { const int st = b / 1024, sb = b % 1024, swz = sb ^ (((sb >> 9) & 1) << 5); R = (st >> 1) * 16 + swz / 64; C = (st & 1) * 32 + (swz % 64) / 2; }
__host__ __device__ __forceinline__ int perm32(int rho) { const int n = rho >> 4, i = rho & 15; return 8 * (i >> 2) + 4 * n + (i & 3); }

struct Unit { int pm, pn; };
struct Gemm { const bf16_t* A; const bf16_t* Bt; int M, N, K; };

struct StaticOrder {
    int nM, nN, nwg, G, c;
    __host__ __device__ void init(int M, int N, int G_, int c_) { nM = M / BM; nN = N / BM; nwg = nM * nN; G = G_; c = c_; }
    __host__ __device__ bool next(int i, Unit& u) const {
        const long L = (long)i * G + c; if (L >= nwg) return false;
        int wgid = (int)L; { const int q = nwg / NXCD, r = nwg % NXCD, xcd = wgid % NXCD, off = wgid / NXCD; wgid = (xcd < r ? xcd * (q + 1) : r * (q + 1) + (xcd - r) * q) + off; }
        const int nig = WGM * nN, gid = wgid / nig, fm = gid * WGM, gsz = (nM - fm) < WGM ? (nM - fm) : WGM;
        u.pm = fm + ((wgid % nig) % gsz); u.pn = (wgid % nig) / gsz; return true;
    }
    __device__ __forceinline__ void a_ready(const Unit&) const {}
    __device__ __forceinline__ void done(const Unit&) const {}
};

__device__ __forceinline__ unsigned cvt_pk_bf16(float lo, float hi) { unsigned r; asm volatile("v_cvt_pk_bf16_f32 %0, %1, %2" : "=v"(r) : "v"(lo), "v"(hi)); return r; }
typedef unsigned u32x2 __attribute__((ext_vector_type(2)));
typedef float f32x2 __attribute__((ext_vector_type(2)));
typedef __bf16 bf16x2_t __attribute__((ext_vector_type(2)));
__device__ __forceinline__ unsigned pk2(float lo, float hi) { f32x2 v = {lo, hi}; bf16x2_t b = __builtin_convertvector(v, bf16x2_t); return __builtin_bit_cast(unsigned, b); }
__device__ __forceinline__ float silu_f(float a) { return a * __builtin_amdgcn_rcpf(1.0f + __expf(-a)); }

struct EpiStoreBf16 {
    static constexpr bool PERM = true, AFTER_DRAIN = false;
    bf16_t* O; size_t ldc; const float* rowbias;
    __device__ __forceinline__ void operator()(const f32x4 (&acc)[2][2][4][2], const Unit& u, int wr, int wc, int fr, int fq) const {
        const int row0 = u.pm * BM + wr * 64 + fr; const int col0 = u.pn * BM + wc * 32 + 8 * fq;
#pragma unroll
        for (int ai = 0; ai < 2; ++ai)
#pragma unroll
            for (int m = 0; m < 4; ++m) { const int row = row0 + ai * HALF + m * 16; const float rb = rowbias ? rowbias[row] : 0.f; bf16_t* rowp = O + (size_t)row * ldc + col0;
#pragma unroll
                for (int bj = 0; bj < 2; ++bj) { const f32x4 v0 = acc[ai][bj][m][0] + rb, v1 = acc[ai][bj][m][1] + rb;
                    u32x4 w; w.x = pk2(v0[0], v0[1]); w.y = pk2(v0[2], v0[3]); w.z = pk2(v1[0], v1[1]); w.w = pk2(v1[2], v1[3]);
                    *(u32x4*)(rowp + bj * HALF) = w; } }
    }
};
struct EpiSwiGLU {
    static constexpr bool PERM = true, AFTER_DRAIN = false;
    bf16_t* H; int ldh;
    __device__ __forceinline__ void operator()(const f32x4 (&acc)[2][2][4][2], const Unit& u, int wr, int wc, int fr, int fq) const {
        const int row0 = u.pm * BM + wr * 64 + fr; const int col0 = u.pn * HALF + wc * 32 + 8 * fq;
#pragma unroll
        for (int ai = 0; ai < 2; ++ai)
#pragma unroll
            for (int m = 0; m < 4; ++m) { const int row = row0 + ai * HALF + m * 16;
                const f32x4 a0 = acc[ai][0][m][0], a1 = acc[ai][0][m][1], b0 = acc[ai][1][m][0], b1 = acc[ai][1][m][1];
                u32x4 w; w.x = pk2(silu_f(a0[0]) * b0[0], silu_f(a0[1]) * b0[1]); w.y = pk2(silu_f(a0[2]) * b0[2], silu_f(a0[3]) * b0[3]);
                w.z = pk2(silu_f(a1[0]) * b1[0], silu_f(a1[1]) * b1[1]); w.w = pk2(silu_f(a1[2]) * b1[2], silu_f(a1[3]) * b1[3]);
                *(u32x4*)(H + (size_t)row * ldh + col0) = w; }
    }
};
template <bool BASE_BF16, bool OUT_BF16> struct EpiResid {
    static constexpr bool PERM = true, AFTER_DRAIN = false;
    const void* base; void* out; const float* gate; const float* bias;
    __device__ __forceinline__ void operator()(const f32x4 (&acc)[2][2][4][2], const Unit& u, int wr, int wc, int fr, int fq) const {
        const int row0 = u.pm * BM + wr * 64 + fr; const int col0 = u.pn * BM + wc * 32 + 8 * fq;
        const float* gp = gate + (size_t)(u.pm >> 5) * 6144;
#pragma unroll
        for (int bj = 0; bj < 2; ++bj) { const int c = col0 + bj * HALF;
            const f32x4 g0 = *(const f32x4*)(gp + c), g1 = *(const f32x4*)(gp + c + 4);
            const f32x4 b0 = bias ? *(const f32x4*)(bias + c) : (f32x4){0.f, 0.f, 0.f, 0.f}, b1 = bias ? *(const f32x4*)(bias + c + 4) : (f32x4){0.f, 0.f, 0.f, 0.f};
#pragma unroll
            for (int ai = 0; ai < 2; ++ai)
#pragma unroll
                for (int m = 0; m < 4; ++m) { const size_t off = (size_t)(row0 + ai * HALF + m * 16) * 1024 + c;
                    f32x4 x0, x1;
                    if (BASE_BF16) { const u32x4 v = *(const u32x4*)((const bf16_t*)base + off);
                        x0 = (f32x4){__uint_as_float(v.x << 16), __uint_as_float(v.x & 0xffff0000u), __uint_as_float(v.y << 16), __uint_as_float(v.y & 0xffff0000u)};
                        x1 = (f32x4){__uint_as_float(v.z << 16), __uint_as_float(v.z & 0xffff0000u), __uint_as_float(v.w << 16), __uint_as_float(v.w & 0xffff0000u)}; }
                    else { x0 = *(const f32x4*)((const float*)base + off); x1 = *(const f32x4*)((const float*)base + off + 4); }
                    x0 = x0 + g0 * (acc[ai][bj][m][0] + b0); x1 = x1 + g1 * (acc[ai][bj][m][1] + b1);
                    if (OUT_BF16) { u32x4 w; w.x = pk2(x0[0], x0[1]); w.y = pk2(x0[2], x0[3]); w.z = pk2(x1[0], x1[1]); w.w = pk2(x1[2], x1[3]); *(u32x4*)((bf16_t*)out + off) = w; }
                    else { *(f32x4*)((float*)out + off) = x0; *(f32x4*)((float*)out + off + 4) = x1; } } }
    }
};
template <class Epi, class Sched, bool ALIGN_EPI = false, bool SP2 = false>
__device__ __forceinline__ void gemm_phase(PG8_LAS unsigned char* lds, const Gemm g, const Sched& S, const Epi& E) {
    const int tid = threadIdx.x, wid = __builtin_amdgcn_readfirstlane(tid >> 6), lane = tid & 63, wr = wid >> 2, wc = wid & 3, fr = lane & 15, fq = lane >> 4;
    const int K = g.K, nt = K / BK;
    unsigned voffA[2], voffB[2];
#pragma unroll
    for (int i = 0; i < 2; ++i) { int R, C; stage_rc(tid * 16 + i * 8192, R, C); const int Rb = Epi::PERM ? ((R & ~31) + perm32(R & 31)) : R;
        voffA[i] = (unsigned)(R * K + C) * 2u; voffB[i] = (unsigned)(Rb * K + C) * 2u; }
    const size_t kstep = (size_t)(BK * 2);
    const size_t hstep = (size_t)HALF * K * 2;
    const size_t tstep = 2 * hstep;
    const unsigned ldsw = (unsigned)wid * 1024u;
    const int aoff = lds_byte(wr * 64 + fr, fq * 8), boff = lds_byte(wc * 32 + fr, fq * 8);
#define PG8_SA(b, h) (((b) * 2 + (h)) * HTB)
#define PG8_SB(b, h) ((4 + (b) * 2 + (h)) * HTB)
#define PG8_STAGE(bufoff, gbase, voff) do { _Pragma("unroll") for (int _i = 0; _i < 2; ++_i) \
        __builtin_amdgcn_global_load_lds((const unsigned*)((const char*)(gbase) + (voff)[_i]), (PG8_LAS unsigned*)(lds + (bufoff) + ldsw + _i * 8192), 16, 0, 0); } while (0)
#define PG8_LDA(dst, b, h) do { _Pragma("unroll") for (int m = 0; m < 4; ++m) _Pragma("unroll") for (int k = 0; k < 2; ++k) dst[m][k] = *(const PG8_LAS bf16x8*)(lds + PG8_SA(b, h) + aoff + m * 2048 + k * 1024); } while (0)
#define PG8_LDB(dst, b, h) do { _Pragma("unroll") for (int n = 0; n < 2; ++n) _Pragma("unroll") for (int k = 0; k < 2; ++k) dst[n][k] = *(const PG8_LAS bf16x8*)(lds + PG8_SB(b, h) + boff + n * 2048 + k * 1024); } while (0)
#define PG8_MMA(ai, bj, At, Bt) do { __builtin_amdgcn_s_setprio(1); _Pragma("unroll") for (int m = 0; m < 4; ++m) _Pragma("unroll") for (int n = 0; n < 2; ++n) _Pragma("unroll") for (int k = 0; k < 2; ++k) \
        acc[ai][bj][m][n] = __builtin_amdgcn_mfma_f32_16x16x32_bf16(Bt[n][k], At[m][k], acc[ai][bj][m][n], 0, 0, 0); __builtin_amdgcn_s_setprio(0); } while (0)
#define PG8_WAIT_V(n) asm volatile("s_waitcnt vmcnt(" #n ")" ::: "memory")
#define PG8_WAIT_L(n) asm volatile("s_waitcnt lgkmcnt(" #n ")" ::: "memory")
#define PG8_BAR __builtin_amdgcn_s_barrier()
#define PG8_SCHED __builtin_amdgcn_sched_barrier(0)
    Unit cur, nxt; int ui = 0;
    if (!S.next(0, cur)) return;
    f32x4 acc[2][2][4][2];
#pragma unroll
    for (int a = 0; a < 2; ++a)
#pragma unroll
        for (int b = 0; b < 2; ++b)
#pragma unroll
            for (int m = 0; m < 4; ++m)
#pragma unroll
                for (int n = 0; n < 2; ++n) acc[a][b][m][n] = (f32x4){0.f, 0.f, 0.f, 0.f};
    bf16x8 At[4][2], B0[2][2], B1[2][2];
    const char* cA = (const char*)g.A + (size_t)cur.pm * tstep; const char* cB = (const char*)g.Bt + (size_t)cur.pn * tstep;
    S.a_ready(cur);
    if constexpr (SP2) {
        PG8_STAGE(PG8_SB(0, 0), cB, voffB); PG8_STAGE(PG8_SB(0, 1), cB + hstep, voffB); PG8_STAGE(PG8_SA(0, 0), cA, voffA); PG8_STAGE(PG8_SA(0, 1), cA + hstep, voffA);
        if (wr == 1) PG8_BAR;
        PG8_WAIT_V(2); PG8_BAR;
        PG8_STAGE(PG8_SB(1, 0), cB + kstep, voffB); PG8_STAGE(PG8_SA(1, 0), cA + kstep, voffA); PG8_STAGE(PG8_SB(1, 1), cB + hstep + kstep, voffB);
        PG8_WAIT_V(6); PG8_BAR;
    } else {
        PG8_STAGE(PG8_SB(0, 0), cB, voffB); PG8_STAGE(PG8_SA(0, 0), cA, voffA); PG8_STAGE(PG8_SB(0, 1), cB + hstep, voffB); PG8_STAGE(PG8_SA(0, 1), cA + hstep, voffA);
        if (wr == 1) PG8_BAR;
        PG8_WAIT_V(4); PG8_BAR;
        PG8_STAGE(PG8_SB(1, 0), cB + kstep, voffB); PG8_STAGE(PG8_SA(1, 0), cA + kstep, voffA); PG8_STAGE(PG8_SB(1, 1), cB + hstep + kstep, voffB);
        PG8_WAIT_V(6); PG8_BAR;
    }
    for (;;) {
        const bool has_next = S.next(ui + 1, nxt);
        const char* nA = has_next ? (const char*)g.A + (size_t)nxt.pm * tstep : cA; const char* nB = has_next ? (const char*)g.Bt + (size_t)nxt.pn * tstep : cB;
        for (int t = 0; t < nt; t += 2) {
            const bool last = (t == nt - 2);
            const char* a1 = cA + (size_t)(t + 1) * kstep;
            const char* a2 = last ? nA : cA + (size_t)(t + 2) * kstep; const char* b2 = last ? nB : cB + (size_t)(t + 2) * kstep;
            const char* a3 = a2 + kstep; const char* b3 = b2 + kstep;
            if (last && has_next) S.a_ready(nxt);
            if constexpr (SP2) {
            PG8_LDB(B0, 0, 0); PG8_LDB(B1, 0, 1); PG8_SCHED; PG8_LDA(At, 0, 0); PG8_STAGE(PG8_SA(1, 1), a1 + hstep, voffA);
            PG8_WAIT_V(8); PG8_WAIT_L(0); PG8_BAR; PG8_MMA(0, 0, At, B0); PG8_MMA(0, 1, At, B1); PG8_BAR; PG8_SCHED;
            PG8_LDA(At, 0, 1); PG8_STAGE(PG8_SB(0, 0), b2, voffB); PG8_STAGE(PG8_SB(0, 1), b2 + hstep, voffB); PG8_STAGE(PG8_SA(0, 0), a2, voffA);
            PG8_WAIT_V(8); PG8_WAIT_L(0); PG8_BAR; PG8_MMA(1, 0, At, B0); PG8_MMA(1, 1, At, B1); PG8_BAR; PG8_SCHED;
            PG8_LDB(B0, 1, 0); PG8_LDB(B1, 1, 1); PG8_SCHED; PG8_LDA(At, 1, 0); PG8_STAGE(PG8_SA(0, 1), a2 + hstep, voffA);
            PG8_WAIT_V(8); PG8_WAIT_L(0); PG8_BAR; PG8_MMA(0, 0, At, B0); PG8_MMA(0, 1, At, B1); PG8_BAR; PG8_SCHED;
            PG8_LDA(At, 1, 1); PG8_STAGE(PG8_SB(1, 0), b3, voffB); PG8_STAGE(PG8_SB(1, 1), b3 + hstep, voffB); PG8_STAGE(PG8_SA(1, 0), a3, voffA);
            PG8_WAIT_V(8); PG8_WAIT_L(0); PG8_BAR; PG8_MMA(1, 0, At, B0); PG8_MMA(1, 1, At, B1); PG8_BAR; PG8_SCHED;
            } else {
            PG8_LDB(B0, 0, 0); PG8_SCHED; PG8_LDA(At, 0, 0); PG8_STAGE(PG8_SA(1, 1), a1 + hstep, voffA);
            PG8_WAIT_L(8); PG8_BAR; PG8_WAIT_L(0); PG8_MMA(0, 0, At, B0); PG8_BAR; PG8_SCHED;
            PG8_LDB(B1, 0, 1); PG8_STAGE(PG8_SB(0, 0), b2, voffB);
            PG8_BAR; PG8_WAIT_L(0); PG8_MMA(0, 1, At, B1); PG8_BAR;
            PG8_LDA(At, 0, 1); PG8_STAGE(PG8_SA(0, 0), a2, voffA);
            PG8_BAR; PG8_WAIT_L(0); PG8_MMA(1, 0, At, B0); PG8_BAR; PG8_SCHED;
            PG8_STAGE(PG8_SB(0, 1), b2 + hstep, voffB);
            PG8_WAIT_V(6); PG8_BAR; PG8_MMA(1, 1, At, B1); PG8_BAR;
            PG8_LDB(B0, 1, 0); PG8_SCHED; PG8_LDA(At, 1, 0); PG8_STAGE(PG8_SA(0, 1), a2 + hstep, voffA);
            PG8_WAIT_L(8); PG8_BAR; PG8_WAIT_L(0); PG8_MMA(0, 0, At, B0); PG8_BAR; PG8_SCHED;
            PG8_LDB(B1, 1, 1); PG8_STAGE(PG8_SB(1, 0), b3, voffB);
            PG8_BAR; PG8_WAIT_L(0); PG8_MMA(0, 1, At, B1); PG8_BAR;
            PG8_LDA(At, 1, 1); PG8_STAGE(PG8_SA(1, 0), a3, voffA);
            PG8_BAR; PG8_WAIT_L(0); PG8_MMA(1, 0, At, B0); PG8_BAR; PG8_SCHED;
            PG8_STAGE(PG8_SB(1, 1), b3 + hstep, voffB);
            PG8_WAIT_V(6); PG8_BAR; PG8_MMA(1, 1, At, B1); PG8_BAR;
            }
        }
        if constexpr (ALIGN_EPI) { if (wr == 0) PG8_BAR; }
        if constexpr (!Epi::AFTER_DRAIN) { E(acc, cur, wr, wc, fr, fq); S.done(cur); }
        if (!has_next) break;
#pragma unroll
        for (int a = 0; a < 2; ++a)
#pragma unroll
            for (int b = 0; b < 2; ++b)
#pragma unroll
                for (int m = 0; m < 4; ++m)
#pragma unroll
                    for (int n = 0; n < 2; ++n) acc[a][b][m][n] = (f32x4){0.f, 0.f, 0.f, 0.f};
        cur = nxt; cA = nA; cB = nB; ++ui;
        if constexpr (ALIGN_EPI) { if (wr == 1) PG8_BAR; }
    }
    PG8_WAIT_V(0);
    if constexpr (!ALIGN_EPI) { if (wr == 0) PG8_BAR; }
    PG8_BAR;
    if constexpr (Epi::AFTER_DRAIN) { E.fused(acc, cur, wr, wc, fr, fq, lds, wid, lane); S.done(cur); }
#undef PG8_SA
#undef PG8_SB
#undef PG8_STAGE
#undef PG8_LDA
#undef PG8_LDB
#undef PG8_MMA
#undef PG8_WAIT_V
#undef PG8_WAIT_L
#undef PG8_BAR
#undef PG8_SCHED
}
}
#define LAS __attribute__((address_space(3)))
typedef pg8::bf16_t bf16_t;
typedef pg8::f32x4 f32x4;
typedef pg8::u32x4 u32x4;
typedef pg8::u32x2 u32x2;
typedef pg8::bf16x8 bf16x8;
typedef float cf __attribute__((ext_vector_type(2)));
typedef float f32x16 __attribute__((ext_vector_type(16)));
typedef short s16x4 __attribute__((ext_vector_type(4)));
using pg8::pk2;

constexpr int D_ = 1024, NBATCH = 8, SEQ = 8192, M_ = NBATCH * SEQ, LCTX = 256, MCTX = NBATCH * LCTX, MT_ = M_ + MCTX;
constexpr int NQKV = 1536, DFF = 2816, NFF1 = 2 * DFF, NFFT = 16384;
constexpr int NPHASE = 17;
constexpr size_t MiB = 1u << 20;
constexpr size_t WS_MOD = 0, WS_SD8 = 512 * 1024, WS_BAR = 768 * 1024, WS_ROPE = 1 * MiB, WS_HDN = 3 * MiB, WS_WQKV = 6 * MiB, WS_WO = 9 * MiB, WS_WFF1 = 11 * MiB, WS_WFF2 = 33 * MiB,
                 WS_WIN = 45 * MiB, WS_WOUT = 51 * MiB, WS_SD = 54 * MiB, WS_XN = 118 * MiB, WS_QKV = 250 * MiB, WS_OB = 448 * MiB, WS_ZT = 250 * MiB,
                 WS_H = 250 * MiB, WS_G = 634 * MiB, WS_GT = 118 * MiB, WS_XS = 762 * MiB, WS_END = 890 * MiB;
constexpr size_t ZLD = M_, GLD = M_;
constexpr int LDS_BYTES = 147456;

__device__ __forceinline__ float bf_lo(unsigned w) { return __uint_as_float(w << 16); }
__device__ __forceinline__ float bf_hi(unsigned w) { return __uint_as_float(w & 0xffff0000u); }
__device__ __forceinline__ float wave_sum(float v) {
#pragma unroll
    for (int o = 1; o < 64; o <<= 1) v += __shfl_xor(v, o);
    return v;
}

struct Args { const float* in[31]; float* out; unsigned char* ws; int ph_lo, ph_hi; };

__device__ __forceinline__ void transpose_item(const float* W, int K, int N, bf16_t* WT, int dst_row0, LAS float* scr, int k0, int n0, int lane) {
    float wv_[32];
#pragma unroll
    for (int i = 0; i < 32; ++i) { const int kk = 2 * i + (lane >> 5); wv_[i] = W[(size_t)(k0 + kk) * N + n0 + (lane & 31)]; }
#pragma unroll
    for (int i = 0; i < 32; ++i) { const int kk = 2 * i + (lane >> 5); scr[kk * 33 + (lane & 31)] = wv_[i]; }
    asm volatile("s_waitcnt lgkmcnt(0)" ::: "memory");
    const int c = lane & 7;
#pragma unroll
    for (int j = 0; j < 4; ++j) { const int n = (lane >> 3) + 8 * j; const LAS float* s = scr + (8 * c) * 33 + n;
        u32x4 o; o.x = pk2(s[0 * 33], s[1 * 33]); o.y = pk2(s[2 * 33], s[3 * 33]); o.z = pk2(s[4 * 33], s[5 * 33]); o.w = pk2(s[6 * 33], s[7 * 33]);
        *(u32x4*)(WT + (size_t)(dst_row0 + n) * K + k0 + 8 * c) = o; }
    asm volatile("s_waitcnt lgkmcnt(0)" ::: "memory");
}

struct TrP { const float* W; bf16_t* WT; int K, N, dr, k0, n0; };
__device__ __forceinline__ TrP tr_params(const Args& a, int it) {
    unsigned char* ws = a.ws; TrP p; int r = it;
#define TRP(Wp, KK, NN, WTp, MODE) { const int ni = ((KK) / 64) * ((NN) / 32); if (r < ni) { const int nblk = (NN) / 32, kb = r / nblk, nb = r % nblk, n0 = 32 * nb; \
        p.W = (Wp); p.WT = (bf16_t*)(WTp); p.K = (KK); p.N = (NN); p.k0 = 64 * kb; p.n0 = n0; p.dr = (MODE) == 0 ? n0 : (256 * (n0 / 128) + (n0 % 128) + ((MODE) == 2 ? 128 : 0)); return p; } r -= ni; }
    TRP(a.in[8], 1024, NQKV, ws + WS_WQKV, 0)
    TRP(a.in[9], 1024, 1024, ws + WS_WO, 0)
    TRP(a.in[28], 1024, DFF, ws + WS_WFF1, 1)
    TRP(a.in[29], 1024, DFF, ws + WS_WFF1, 2)
    TRP(a.in[28] + (size_t)1024 * DFF, 1024, DFF, ws + WS_WFF1 + 11 * MiB, 1)
    TRP(a.in[29] + (size_t)1024 * DFF, 1024, DFF, ws + WS_WFF1 + 11 * MiB, 2)
    TRP(a.in[30], DFF, 1024, ws + WS_WFF2, 0)
    TRP(a.in[30] + (size_t)1024 * DFF, DFF, 1024, ws + WS_WFF2 + 6 * MiB, 0)
    TRP(a.in[13], 1024, 3072, ws + WS_WIN, 0)
    { const int nblk = 32, kb = r / nblk, nb = r % nblk, n0 = 32 * nb; p.W = a.in[26]; p.WT = (bf16_t*)(ws + WS_WOUT); p.K = 1024; p.N = 1024; p.k0 = 64 * kb; p.n0 = n0; p.dr = n0; }
#undef TRP
    return p;
}
template <int SUB = 15> __device__ __forceinline__ void phase0(LAS unsigned char* L, const Args& a) {
    const int tid = threadIdx.x, lane = tid & 63, w = __builtin_amdgcn_readfirstlane(tid >> 6);
    const int bx = blockIdx.x, G = gridDim.x;
    unsigned char* ws = a.ws;
    if (SUB & 1) {
        LAS float* SC = (LAS float*)L;
        LAS float* RED = (LAS float*)(L + 9 * 1024 * 4);
        if (bx < 192) {
            const float* c = a.in[1]; const float* cc = a.in[3];
            for (int idx = tid; idx < 9 * 1024; idx += 512) { const int j = idx >> 10, k = idx & 1023; const float v = j < 8 ? c[j * 1024 + k] : cc[k]; SC[idx] = v / (1.0f + expf(-v)); }
            __syncthreads();
            float* MOD = (float*)(ws + WS_MOD);
            for (int unit = bx; unit < 192; unit += G) {
                const int l = unit / 96, ng = unit % 96, n = ng * 64 + lane;
                const float* aw = a.in[4] + (size_t)l * 1024 * 6144 + n;
                float acc[9];
#pragma unroll
                for (int j = 0; j < 9; ++j) acc[j] = 0.f;
#pragma unroll 1
                for (int kb = 0; kb < 128; kb += 32) { float wv[32];
#pragma unroll
                    for (int kk = 0; kk < 32; ++kk) wv[kk] = aw[(size_t)(w * 128 + kb + kk) * 6144];
#pragma unroll
                    for (int kk = 0; kk < 32; ++kk) { const int k = w * 128 + kb + kk;
#pragma unroll
                        for (int j = 0; j < 9; ++j) acc[j] += SC[j * 1024 + k] * wv[kk]; } }
#pragma unroll
                for (int j = 0; j < 9; ++j) RED[(w * 9 + j) * 64 + lane] = acc[j];
                __syncthreads();
                for (int idx = tid; idx < 576; idx += 512) { const int j = idx >> 6, nn = idx & 63; float s = 0.f;
#pragma unroll
                    for (int ww = 0; ww < 8; ++ww) s += RED[(ww * 9 + j) * 64 + nn];
                    MOD[(size_t)(l * 9 + j) * 6144 + ng * 64 + nn] = s + a.in[5][l * 6144 + ng * 64 + nn]; }
                __syncthreads();
            }
        }
        __syncthreads();
    }
    if (SUB & 2) {
        LAS float* ZB = (LAS float*)L;
        LAS float* H1 = (LAS float*)(L + 2048);
        LAS float* W1L = (LAS float*)(L + 4096);
        LAS float* W2L = (LAS float*)(L + 4096 + 33 * 64 * 4);
        for (int idx = tid; idx < 33 * 64; idx += 512) W1L[idx] = a.in[17][idx];
        for (int idx = tid; idx < 64 * 64; idx += 512) W2L[idx] = a.in[20][idx];
        __syncthreads();
        bf16_t* HDN = (bf16_t*)(ws + WS_HDN);
        const float* b1 = a.in[18]; const float* f1 = a.in[19]; const float* b2 = a.in[21]; const float* f2 = a.in[22];
        const int pos = w, j = lane;
        for (int unit = bx; unit < 1024; unit += G) {
            const int m = unit * 8 + pos;
            if (lane < 33) {
                float zv;
                if (lane == 0) zv = (float)m / (float)(SEQ - 1);
                else { const int i = (lane - 1) & 15; const float band = 1e-4f + (float)i * ((15.0f - 1e-4f) / 15.0f); const float wm = 6.283185307179586f * (float)m / (float)SEQ; const float ang = band * wm;
                    zv = (lane <= 16) ? __cosf(ang) : -__sinf(ang); }
                ZB[pos * 36 + lane] = zv;
            }
            __syncthreads();
            float s = b1[j];
#pragma unroll
            for (int e = 0; e < 33; ++e) s += ZB[pos * 36 + e] * W1L[e * 64 + j];
            H1[pos * 64 + j] = __sinf(f1[j] * s);
            __syncthreads();
            float s2 = b2[j];
#pragma unroll 8
            for (int e = 0; e < 64; ++e) s2 += H1[pos * 64 + e] * W2L[e * 64 + j];
            HDN[(size_t)m * 64 + j] = (bf16_t)(pk2(__sinf(f2[j] * s2), 0.f) & 0xffffu);
            __syncthreads();
        }
    }
    if (SUB & 4) {
        LAS float* scr = (LAS float*)(L + w * 16384);
        const int gw = bx * 8 + w, NGW = G * 8;
        constexpr int I_QKV = 16 * (NQKV / 32), I_SQ = 16 * 32, I_F1 = 16 * (DFF / 32), I_F2 = (DFF / 64) * 32, I_IN = 16 * (3072 / 32);
        constexpr int NITEMS = I_QKV + I_SQ + 4 * I_F1 + 2 * I_F2 + I_IN + I_SQ;
        float wv[32]; TrP cur = tr_params(a, gw < NITEMS ? gw : 0);
#define TR_LOAD(p_) do { _Pragma("unroll") for (int i = 0; i < 32; ++i) { const int kk = 2 * i + (lane >> 5); wv[i] = (p_).W[(size_t)((p_).k0 + kk) * (p_).N + (p_).n0 + (lane & 31)]; } } while (0)
        if (gw < NITEMS) TR_LOAD(cur);
        for (int it = gw; it < NITEMS; it += NGW) {
#pragma unroll
            for (int i = 0; i < 32; ++i) { const int kk = 2 * i + (lane >> 5); scr[kk * 33 + (lane & 31)] = wv[i]; }
            TrP nxt = cur;
            if (it + NGW < NITEMS) { nxt = tr_params(a, it + NGW); TR_LOAD(nxt); }
            asm volatile("s_waitcnt lgkmcnt(0)" ::: "memory");
            const int c = lane & 7;
#pragma unroll
            for (int j = 0; j < 4; ++j) { const int n = (lane >> 3) + 8 * j; const LAS float* sp = scr + (8 * c) * 33 + n;
                u32x4 o; o.x = pk2(sp[0 * 33], sp[1 * 33]); o.y = pk2(sp[2 * 33], sp[3 * 33]); o.z = pk2(sp[4 * 33], sp[5 * 33]); o.w = pk2(sp[6 * 33], sp[7 * 33]);
                *(u32x4*)(cur.WT + (size_t)(cur.dr + n) * cur.K + cur.k0 + 8 * c) = o; }
            asm volatile("s_waitcnt lgkmcnt(0)" ::: "memory");
            cur = nxt;
        }
#undef TR_LOAD
    }
    if (SUB & 8) {
        float* ROPE = (float*)(ws + WS_ROPE);
        for (int idx = bx * 512 + tid; idx < SEQ * 32; idx += G * 512) { const int t = idx >> 5, i = idx & 31; const int pos = (i < 16) ? (t >> 6) : (t & 63); const int f = i & 15;
            const float inv = powf(10000.0f, -(float)f / 16.0f); const float ang = (float)pos * inv; ROPE[t * 64 + i] = cosf(ang); ROPE[t * 64 + 32 + i] = sinf(ang); }
    }
}

__device__ __forceinline__ int PH(int p) { return p ^ (((p >> 6) & 15) << 2); }
__device__ __forceinline__ cf cmul(cf a, cf b) { cf t, r;
    asm("v_pk_mul_f32 %0, %1, %2 op_sel:[0,0] op_sel_hi:[0,1]" : "=v"(t) : "v"(a), "v"(b));
    asm("v_pk_fma_f32 %0, %1, %2, %3 op_sel:[1,1,0] op_sel_hi:[1,0,1] neg_lo:[1,0,0]" : "=v"(r) : "v"(a), "v"(b), "v"(t)); return r; }
__device__ __forceinline__ cf cmulc(cf a, cf b) { cf t, r;
    asm("v_pk_mul_f32 %0, %1, %2 op_sel:[0,0] op_sel_hi:[0,1] neg_hi:[0,1]" : "=v"(t) : "v"(a), "v"(b));
    asm("v_pk_fma_f32 %0, %1, %2, %3 op_sel:[1,1,0] op_sel_hi:[1,0,1]" : "=v"(r) : "v"(a), "v"(b), "v"(t)); return r; }
__device__ __forceinline__ cf cconj(cf a) { return (cf){a.x, -a.y}; }
__device__ __forceinline__ cf add_mib(cf a, cf b) { cf r; asm("v_pk_add_f32 %0, %1, %2 op_sel:[0,1] op_sel_hi:[1,0] neg_hi:[0,1]" : "=v"(r) : "v"(a), "v"(b)); return r; }
__device__ __forceinline__ cf add_pib(cf a, cf b) { cf r; asm("v_pk_add_f32 %0, %1, %2 op_sel:[0,1] op_sel_hi:[1,0] neg_lo:[0,1]" : "=v"(r) : "v"(a), "v"(b)); return r; }
template <bool INV> __device__ __forceinline__ void dft4(cf& a0, cf& a1, cf& a2, cf& a3) {
    const cf s0 = a0 + a2, s1 = a0 - a2, s2 = a1 + a3, s3 = a1 - a3;
    a0 = s0 + s2; a2 = s0 - s2;
    if (!INV) { a1 = add_mib(s1, s3); a3 = add_pib(s1, s3); }
    else      { a1 = add_pib(s1, s3); a3 = add_mib(s1, s3); }
}
template <bool INV> __device__ __forceinline__ cf tw16(cf v, float c, float s) {
    const float ss = INV ? s : -s; return (cf){v.x * c - v.y * ss, v.x * ss + v.y * c};
}
template <bool INV, bool HALFIN = false> __device__ __forceinline__ void dft16(cf (&x)[16]) {
#pragma unroll
    for (int m2 = 0; m2 < 4; ++m2) {
        if (HALFIN) { const cf a0 = x[m2], a1 = x[4 + m2]; x[m2] = a0 + a1; x[8 + m2] = a0 - a1; x[4 + m2] = add_mib(a0, a1); x[12 + m2] = add_pib(a0, a1); }
        else dft4<INV>(x[m2], x[4 + m2], x[8 + m2], x[12 + m2]);
    }
    constexpr float C1 = 0.9238795325112867f, S1 = 0.3826834323650898f, C2 = 0.7071067811865476f;
    x[4 * 1 + 1] = tw16<INV>(x[5], C1, S1);  x[4 * 1 + 2] = tw16<INV>(x[6], C2, C2);   x[4 * 1 + 3] = tw16<INV>(x[7], S1, C1);
    x[4 * 2 + 1] = tw16<INV>(x[9], C2, C2);  x[4 * 2 + 2] = tw16<INV>(x[10], 0.f, 1.f); x[4 * 2 + 3] = tw16<INV>(x[11], -C2, C2);
    x[4 * 3 + 1] = tw16<INV>(x[13], S1, C1); x[4 * 3 + 2] = tw16<INV>(x[14], -C2, C2); x[4 * 3 + 3] = tw16<INV>(x[15], -C1, -S1);
#pragma unroll
    for (int q1 = 0; q1 < 4; ++q1) dft4<INV>(x[4 * q1], x[4 * q1 + 1], x[4 * q1 + 2], x[4 * q1 + 3]);
}
template <int LST> __device__ __forceinline__ int pass_pos(int base, int phb, int m) {
    if (LST == 10) return phb + (m << 10);
    if (LST == 6) return (base ^ (m << 2)) + (m << 6);
    return PH(base + (m << LST));
}
template <bool INV, int LST, bool HALF = false> __device__ __forceinline__ void fft_pass16(LAS cf* z, const LAS cf* Thi, const LAS cf* Tlo, int tid) {
    constexpr int st = 1 << LST;
    cf w[16];
#pragma unroll 1
    for (int it = 0; it < 2; ++it) {
        const int g = tid + 512 * it; const int j0 = g & (st - 1); const int base = ((g >> LST) << (LST + 4)) + j0; const int phb = PH(base);
        if (LST == 10 || it == 0) {
            const int e1 = j0 << (10 - LST);
            w[1] = cmul(Thi[e1 >> 7], Tlo[e1 & 127]);
            w[2] = cmul(w[1], w[1]); w[3] = cmul(w[2], w[1]); w[4] = cmul(w[2], w[2]); w[5] = cmul(w[4], w[1]); w[6] = cmul(w[3], w[3]); w[7] = cmul(w[4], w[3]); w[8] = cmul(w[4], w[4]);
#pragma unroll
            for (int q = 9; q < 16; ++q) w[q] = cmul(w[8], w[q - 8]);
        }
        cf x[16];
        if (!INV) {
#pragma unroll
            for (int m = 0; m < 16; ++m) { if (HALF && m >= 8) x[m] = (cf){0.f, 0.f}; else x[m] = z[pass_pos<LST>(base, phb, m)]; }
            dft16<false, HALF>(x);
#pragma unroll
            for (int q = 0; q < 16; ++q) { cf y = x[4 * (q & 3) + (q >> 2)]; if (q) y = cmul(y, w[q]); z[pass_pos<LST>(base, phb, q)] = y; }
        } else {
#pragma unroll
            for (int q = 0; q < 16; ++q) { cf y = z[pass_pos<LST>(base, phb, q)]; if (q) y = cmulc(y, w[q]); x[q] = y; }
            dft16<true>(x);
#pragma unroll
            for (int m = 0; m < (HALF ? 8 : 16); ++m) z[pass_pos<LST>(base, phb, m)] = x[4 * (m & 3) + (m >> 2)];
        }
    }
    __syncthreads();
}
template <bool INV> __device__ __forceinline__ void fft_pass4(LAS cf* z, int tid) {
#pragma unroll 2
    for (int it = 0; it < 8; ++it) {
        const int g = tid + 512 * it; const int pb = PH(4 * g);
        f32x4 v0 = *(LAS f32x4*)(z + pb), v1 = *(LAS f32x4*)(z + pb + 2);
        cf a0 = {v0[0], v0[1]}, a1 = {v0[2], v0[3]}, a2 = {v1[0], v1[1]}, a3 = {v1[2], v1[3]};
        dft4<INV>(a0, a1, a2, a3);
        *(LAS f32x4*)(z + pb) = (f32x4){a0.x, a0.y, a1.x, a1.y}; *(LAS f32x4*)(z + pb + 2) = (f32x4){a2.x, a2.y, a3.x, a3.y};
    }
    __syncthreads();
}
__device__ __forceinline__ void fft_forward(LAS cf* z, const LAS cf* Thi, const LAS cf* Tlo, int tid) {
    fft_pass16<false, 10>(z, Thi, Tlo, tid); fft_pass16<false, 6>(z, Thi, Tlo, tid); fft_pass16<false, 2>(z, Thi, Tlo, tid); fft_pass4<false>(z, tid);
}
__device__ __forceinline__ void fft_inverse(LAS cf* z, const LAS cf* Thi, const LAS cf* Tlo, int tid) {
    fft_pass4<true>(z, tid); fft_pass16<true, 2>(z, Thi, Tlo, tid); fft_pass16<true, 6>(z, Thi, Tlo, tid); fft_pass16<true, 10>(z, Thi, Tlo, tid);
}
__device__ __forceinline__ int k_of_p(int p) { return (p >> 10) | (((p >> 6) & 15) << 4) | (((p >> 2) & 15) << 8) | ((p & 3) << 12); }
__device__ __forceinline__ int p_of_k(int k) { return ((k & 15) << 10) | (((k >> 4) & 15) << 6) | (((k >> 8) & 15) << 2) | (k >> 12); }
__device__ __forceinline__ void fft_tables(LAS cf* Thi, LAS cf* Tlo, int tid) {
    if (tid < 256) { const int aidx = tid & 127; const float ang = (tid < 128) ? (-6.283185307179586f * (float)aidx / 128.0f) : (-6.283185307179586f * (float)aidx / 16384.0f);
        float s, c; sincosf(ang, &s, &c); if (tid < 128) Thi[aidx] = (cf){c, s}; else Tlo[aidx] = (cf){c, s}; }
    __syncthreads();
}

__device__ __forceinline__ void filter_phase(LAS unsigned char* L, const Args& a) {
    const int tid = threadIdx.x;
    LAS cf* z = (LAS cf*)L; LAS cf* Thi = (LAS cf*)(L + 131072); LAS cf* Tlo = Thi + 128;
    LAS float* WT = (LAS float*)(L + 131072 + 2048);
    LAS float* RS = WT + 512;
    const bf16_t* HDN = (const bf16_t*)(a.ws + WS_HDN); const float* wout = a.in[23]; const float* decay = a.in[24];
    f32x4* SD = (f32x4*)(a.ws + WS_SD); f32x4* SD8 = (f32x4*)(a.ws + WS_SD8);
    fft_tables(Thi, Tlo, tid);
    for (int pair = blockIdx.x; pair < 512; pair += gridDim.x) {
        const int ca = 2 * pair;
        {
            LAS bf16_t* WTt = (LAS bf16_t*)WT;
            for (int idx = tid; idx < 1024; idx += 512) { const int n = idx >> 6, k = idx & 63;
                const float v = (n < 4) ? wout[(size_t)k * 2048 + ((n & 2) ? 1024 : 0) + ca + (n & 1)] : 0.f; WTt[idx] = (bf16_t)(pk2(v, 0.f) & 0xffffu); }
        }
        __syncthreads();
        const float da = fabsf(decay[ca]), db = fabsf(decay[ca + 1]);
        float sa = 0.f, sb = 0.f;
        {
            const int lane = tid & 63, w = tid >> 6, n = lane & 15, q = lane >> 4;
            const bf16x8 b0 = *(const LAS bf16x8*)((const LAS bf16_t*)WT + n * 64 + 8 * q), b1 = *(const LAS bf16x8*)((const LAS bf16_t*)WT + n * 64 + 32 + 8 * q);
            const float dsel = (n & 1) ? db : da; float ssum = 0.f;
            LAS float* zf = (LAS float*)z;
#pragma unroll 1
            for (int mg = 0; mg < 4; ++mg) {
            bf16x8 a0v[16], a1v[16];
#pragma unroll
            for (int u = 0; u < 16; ++u) { const bf16_t* hp = HDN + (size_t)(16 * (w + 8 * (mg * 16 + u)) + n) * 64 + 8 * q; a0v[u] = *(const bf16x8*)hp; a1v[u] = *(const bf16x8*)(hp + 32); }
#pragma unroll
            for (int u = 0; u < 16; ++u) {
                const int mt = w + 8 * (mg * 16 + u); const int m0 = 16 * mt; const bf16x8 a0 = a0v[u], a1 = a1v[u];
                f32x4 acc = {0.f, 0.f, 0.f, 0.f};
                acc = __builtin_amdgcn_mfma_f32_16x16x32_bf16(a0, b0, acc, 0, 0, 0); acc = __builtin_amdgcn_mfma_f32_16x16x32_bf16(a1, b1, acc, 0, 0, 0);
                {
                    const int ml = lane >> 2, nn = lane & 3, src = nn + 16 * (ml >> 2);
                    const float v0 = __shfl(acc[0], src), v1 = __shfl(acc[1], src), v2 = __shfl(acc[2], src), v3 = __shfl(acc[3], src);
                    const int isel = ml & 3; float v = isel == 0 ? v0 : isel == 1 ? v1 : isel == 2 ? v2 : v3;
                    const int m = m0 + ml; const float t = (float)m / (float)(SEQ - 1); v *= expf(-t * ((nn & 1) ? db : da));
                    if (nn < 2) { zf[2 * PH(m) + nn] = v; ssum += fabsf(v); }
                    else if (m >= 1) { zf[2 * PH(NFFT - m) + (nn - 2)] = v; ssum += fabsf(v); }
                }
            }
            }
            if (tid == 0) z[PH(SEQ)] = (cf){0.f, 0.f};
            sa = !(lane & 1) ? ssum : 0.f; sb = (lane & 1) ? ssum : 0.f;
        }
        sa = wave_sum(sa); sb = wave_sum(sb);
        if ((tid & 63) == 0) { RS[(tid >> 6) * 2] = sa; RS[(tid >> 6) * 2 + 1] = sb; }
        __syncthreads();
        float ta = 0.f, tb = 0.f;
#pragma unroll
        for (int ww = 0; ww < 8; ++ww) { ta += RS[ww * 2]; tb += RS[ww * 2 + 1]; }
        const float na = 1.0f / (ta * (float)NFFT), nb = 1.0f / (tb * (float)NFFT);
        fft_forward(z, Thi, Tlo, tid);
#define FILT_SD(zk, zn, OUT) do { const cf A_ = (cf){0.5f * ((zk).x + (zn).x), 0.5f * ((zk).y - (zn).y)}; const cf t2_ = (cf){0.5f * ((zk).x - (zn).x), 0.5f * ((zk).y + (zn).y)}; \
            const cf B_ = (cf){t2_.y, -t2_.x}; const cf Ka_ = A_ * na, Kb_ = B_ * nb; \
            OUT = (f32x4){0.5f * (Ka_.x + Kb_.x), 0.5f * (Ka_.y + Kb_.y), 0.5f * (Ka_.x - Kb_.x), 0.5f * (Ka_.y - Kb_.y)}; } while (0)
#pragma unroll
        for (int i = 0; i < 8; ++i) {
            const int g = tid + 512 * i;
            const int kg = (g >> 8) | (((g >> 4) & 15) << 4) | ((g & 15) << 8);
            const int pp0 = p_of_k((NFFT - kg) & (NFFT - 1)), pp1 = p_of_k(12288 - kg);
            const f32x4 zz = *(LAS f32x4*)(z + PH(4 * g));
            const cf zk0 = {zz[0], zz[1]}, zk1 = {zz[2], zz[3]}; const cf zn0 = z[PH(pp0)], zn1 = z[PH(pp1)];
            f32x4 o0, o1; FILT_SD(zk0, zn0, o0); FILT_SD(zk1, zn1, o1);
            f32x4* dst = SD + (size_t)pair * 8192 + 2 * g; dst[0] = o0; dst[1] = o1;
        }
        if (tid == 0) { const cf zk = z[PH(2)]; f32x4 o; FILT_SD(zk, zk, o); SD8[pair] = o; }
#undef FILT_SD
        __syncthreads();
    }
}

__device__ __forceinline__ void norm_rows(const float* x, int nrows, const float* g, const float* sc, const float* sh, bf16_t* o, int lane) {
    f32x4 gs[4], shv[4];
#pragma unroll
    for (int j = 0; j < 4; ++j) { const int k = 4 * lane + 256 * j; const f32x4 gg = *(const f32x4*)(g + k), s = *(const f32x4*)(sc + k); gs[j] = gg * (1.0f + s); shv[j] = *(const f32x4*)(sh + k); }
    int r0 = 0;
#pragma unroll 1
    for (; r0 + 4 <= nrows; r0 += 4) {
        f32x4 v[4][4];
#pragma unroll
        for (int rr = 0; rr < 4; ++rr) { const f32x4* xr = (const f32x4*)(x + (size_t)(r0 + rr) * 1024) + lane;
#pragma unroll
            for (int j = 0; j < 4; ++j) v[rr][j] = xr[64 * j]; }
#pragma unroll
        for (int rr = 0; rr < 4; ++rr) { float ss = 0.f;
#pragma unroll
            for (int j = 0; j < 4; ++j) ss += (v[rr][j].x * v[rr][j].x + v[rr][j].y * v[rr][j].y) + (v[rr][j].z * v[rr][j].z + v[rr][j].w * v[rr][j].w);
            const float rstd = rsqrtf(wave_sum(ss) * (1.0f / 1024.0f) + 1e-6f);
            u32x2* op = (u32x2*)(o + (size_t)(r0 + rr) * 1024) + lane;
#pragma unroll
            for (int j = 0; j < 4; ++j) { const f32x4 y = v[rr][j] * rstd * gs[j] + shv[j]; u32x2 wv; wv.x = pk2(y.x, y.y); wv.y = pk2(y.z, y.w); op[64 * j] = wv; } }
    }
    for (int r = r0; r < nrows; ++r) {
        const f32x4* xr = (const f32x4*)(x + (size_t)r * 1024) + lane; f32x4 v[4]; float ss = 0.f;
#pragma unroll
        for (int j = 0; j < 4; ++j) { v[j] = xr[64 * j]; ss += (v[j].x * v[j].x + v[j].y * v[j].y) + (v[j].z * v[j].z + v[j].w * v[j].w); }
        const float rstd = rsqrtf(wave_sum(ss) * (1.0f / 1024.0f) + 1e-6f);
        u32x2* op = (u32x2*)(o + (size_t)r * 1024) + lane;
#pragma unroll
        for (int j = 0; j < 4; ++j) { const f32x4 y = v[j] * rstd * gs[j] + shv[j]; u32x2 wv; wv.x = pk2(y.x, y.y); wv.y = pk2(y.z, y.w); op[64 * j] = wv; }
    }
}
__device__ __forceinline__ void norm_rows_bf16(const bf16_t* x, int nrows, const float* g, const float* sc, const float* sh, bf16_t* o, int lane) {
    f32x4 gs[4], shv[4];
#pragma unroll
    for (int j = 0; j < 4; ++j) { const int k = 8 * lane + 512 * (j >> 1) + 4 * (j & 1); const f32x4 gg = *(const f32x4*)(g + k), s = *(const f32x4*)(sc + k); gs[j] = gg * (1.0f + s); shv[j] = *(const f32x4*)(sh + k); }
#pragma unroll 1
    for (int r0 = 0; r0 < nrows; r0 += 8) {
        u32x4 raw[8][2];
#pragma unroll
        for (int rr = 0; rr < 8; ++rr) { const u32x4* xr = (const u32x4*)(x + (size_t)(r0 + rr) * 1024) + lane; raw[rr][0] = xr[0]; raw[rr][1] = xr[64]; }
        float rs[8];
#pragma unroll
        for (int rr = 0; rr < 8; ++rr) { float ss = 0.f;
#pragma unroll
            for (int j = 0; j < 2; ++j) { const u32x4 t = raw[rr][j]; const float e0 = bf_lo(t.x), e1 = bf_hi(t.x), e2 = bf_lo(t.y), e3 = bf_hi(t.y), e4 = bf_lo(t.z), e5 = bf_hi(t.z), e6 = bf_lo(t.w), e7 = bf_hi(t.w);
                ss += (e0 * e0 + e1 * e1) + (e2 * e2 + e3 * e3) + (e4 * e4 + e5 * e5) + (e6 * e6 + e7 * e7); }
            rs[rr] = ss; }
#pragma unroll
        for (int of = 1; of < 64; of <<= 1) {
#pragma unroll
            for (int rr = 0; rr < 8; ++rr) rs[rr] += __shfl_xor(rs[rr], of); }
#pragma unroll
        for (int rr = 0; rr < 8; ++rr) { const float rstd = rsqrtf(rs[rr] * (1.0f / 1024.0f) + 1e-6f);
            u32x4* op = (u32x4*)(o + (size_t)(r0 + rr) * 1024) + lane;
#pragma unroll
            for (int j = 0; j < 2; ++j) { const u32x4 t = raw[rr][j];
                const f32x4 v0 = (f32x4){bf_lo(t.x), bf_hi(t.x), bf_lo(t.y), bf_hi(t.y)}, v1 = (f32x4){bf_lo(t.z), bf_hi(t.z), bf_lo(t.w), bf_hi(t.w)};
                const f32x4 y0 = v0 * rstd * gs[2 * j] + shv[2 * j], y1 = v1 * rstd * gs[2 * j + 1] + shv[2 * j + 1];
                u32x4 wv; wv.x = pk2(y0.x, y0.y); wv.y = pk2(y0.z, y0.w); wv.z = pk2(y1.x, y1.y); wv.w = pk2(y1.z, y1.w); op[64 * j] = wv; }
            __builtin_amdgcn_sched_barrier(0); }
    }
}
__device__ __forceinline__ void norm_phase_bf16(const Args& a, int layer, int which) {
    const int tid = threadIdx.x, lane = tid & 63, w = tid >> 6; const int gw = blockIdx.x * 8 + w, NGW = gridDim.x * 8;
    const float* MOD = (const float*)(a.ws + WS_MOD) + (size_t)layer * 9 * 6144;
    const float* g = (which ? a.in[7] : a.in[6]) + layer * 1024;
    bf16_t* XN = (bf16_t*)(a.ws + WS_XN); const bf16_t* XS = (const bf16_t*)(a.ws + WS_XS);
    const int c0 = which ? 3 : 0;
    for (int chunk = gw; chunk < M_ / 32; chunk += NGW) { const int row = chunk * 32, b = row / SEQ; const float* mb = MOD + (size_t)b * 6144;
        norm_rows_bf16(XS + (size_t)row * 1024, 32, g, mb + (c0 + 1) * 1024, mb + c0 * 1024, XN + (size_t)row * 1024, lane); }
}
__device__ __forceinline__ void norm_phase(const Args& a, const float* x, int layer, int which  , bool with_ctx) {
    const int tid = threadIdx.x, lane = tid & 63, w = tid >> 6; const int gw = blockIdx.x * 8 + w, NGW = gridDim.x * 8;
    const float* MOD = (const float*)(a.ws + WS_MOD) + (size_t)layer * 9 * 6144;
    const float* g = (which ? a.in[7] : a.in[6]) + layer * 1024;
    bf16_t* XN = (bf16_t*)(a.ws + WS_XN);
    const int c0 = which ? 3 : 0;
    for (int chunk = gw; chunk < M_ / 32; chunk += NGW) { const int row = chunk * 32, b = row / SEQ; const float* mb = MOD + (size_t)b * 6144;
        norm_rows(x + (size_t)row * 1024, 32, g, mb + (c0 + 1) * 1024, mb + c0 * 1024, XN + (size_t)row * 1024, lane); }
    if (with_ctx) { const float* mb = MOD + (size_t)8 * 6144;
        for (int row = gw; row < MCTX; row += NGW) norm_rows(a.in[2] + (size_t)row * 1024, 1, g, mb + (c0 + 1) * 1024, mb + c0 * 1024, XN + (size_t)(M_ + row) * 1024, lane); }
}

__device__ __forceinline__ void kprep_phase(const Args& a) {
    const int tid = threadIdx.x, lane = tid & 63, w = tid >> 6; const int gw = blockIdx.x * 8 + w, NGW = gridDim.x * 8;
    bf16_t* QKV = (bf16_t*)(a.ws + WS_QKV); const float* ROPE = (const float*)(a.ws + WS_ROPE); const float* kgain = a.in[11];
    const int d4 = 4 * (lane & 15); const f32x4 g = *(const f32x4*)(kgain + d4); const bool lowhalf = (lane & 8) == 0; const int j = d4 & 31;
#pragma unroll 2
    for (int row = gw; row < MT_; row += NGW) {
        u32x2* p = (u32x2*)(QKV + (size_t)row * NQKV + 1024 + 4 * lane);
        const u32x2 v = *p; float f0 = bf_lo(v.x), f1 = bf_hi(v.x), f2 = bf_lo(v.y), f3 = bf_hi(v.y);
        float ss = (f0 * f0 + f1 * f1) + (f2 * f2 + f3 * f3);
        ss += __shfl_xor(ss, 1); ss += __shfl_xor(ss, 2); ss += __shfl_xor(ss, 4); ss += __shfl_xor(ss, 8);
        const float rstd = rsqrtf(ss * (1.0f / 64.0f) + 1e-6f);
        f0 *= rstd * g[0]; f1 *= rstd * g[1]; f2 *= rstd * g[2]; f3 *= rstd * g[3];
        if (row < M_) {
            const float p0 = __shfl_xor(f0, 8), p1 = __shfl_xor(f1, 8), p2 = __shfl_xor(f2, 8), p3 = __shfl_xor(f3, 8);
            const float* rp = ROPE + (size_t)(row & (SEQ - 1)) * 64 + j; const f32x4 cs = *(const f32x4*)rp, sn = *(const f32x4*)(rp + 32);
            if (lowhalf) { f0 = f0 * cs[0] - p0 * sn[0]; f1 = f1 * cs[1] - p1 * sn[1]; f2 = f2 * cs[2] - p2 * sn[2]; f3 = f3 * cs[3] - p3 * sn[3]; }
            else         { f0 = p0 * sn[0] + f0 * cs[0]; f1 = p1 * sn[1] + f1 * cs[1]; f2 = p2 * sn[2] + f2 * cs[2]; f3 = p3 * sn[3] + f3 * cs[3]; }
        }
        u32x2 o; o.x = pk2(f0, f1); o.y = pk2(f2, f3); *p = o;
    }
}

__device__ __forceinline__ int crow(int r, int hi) { return (r & 3) + 8 * (r >> 2) + 4 * hi; }
template <int MODE = 3> __device__ __forceinline__ void attn_phase(LAS unsigned char* L, const Args& a, int vcu, int G) {
    const int tid = threadIdx.x, lane = tid & 63, w = __builtin_amdgcn_readfirstlane(tid >> 6), r32 = lane & 31, hi = lane >> 5;
    constexpr int KS = 144, VS = 136, KBYTES = 64 * KS, VBYTES = 64 * VS, VOFF = 2 * KBYTES;
    const bf16_t* QKV = (const bf16_t*)(a.ws + WS_QKV); bf16_t* OB = (bf16_t*)(a.ws + WS_OB); const float* ROPE = (const float*)(a.ws + WS_ROPE);
    const float* qgain = a.in[10]; const float* sink = a.in[12];
    const float C2 = 0.125f * 1.4426950408889634f;
    const int krow = w * 8 + (lane >> 3), kch = lane & 7;
    for (int unit = vcu; unit < 4096; unit += G) {
        const int b = unit >> 9, kvh = (unit >> 7) & 3, qb = unit & 127, q0 = qb * 64;
        const int head = kvh * 4 + (w & 3), qrow = q0 + 32 * (w >> 2) + r32;
        const int jlo = (q0 < 128) ? ((128 - q0) >> 6) : 0; const int jhi = (q0 > SEQ - 192) ? ((SEQ + 64 - q0) >> 6) : 4; const int ntiles = 4 + (jhi - jlo + 1);
        bf16x8 qr[4];
        {
            const bf16_t* qp = QKV + (size_t)(b * SEQ + qrow) * NQKV + head * 64;
            float qf[4][8]; float ss = 0.f;
#pragma unroll
            for (int d0 = 0; d0 < 4; ++d0) { const u32x4 v = *(const u32x4*)(qp + 8 * (2 * d0 + hi));
                qf[d0][0] = bf_lo(v.x); qf[d0][1] = bf_hi(v.x); qf[d0][2] = bf_lo(v.y); qf[d0][3] = bf_hi(v.y); qf[d0][4] = bf_lo(v.z); qf[d0][5] = bf_hi(v.z); qf[d0][6] = bf_lo(v.w); qf[d0][7] = bf_hi(v.w);
#pragma unroll
                for (int i = 0; i < 8; ++i) ss += qf[d0][i] * qf[d0][i]; }
            ss += __shfl_xor(ss, 32);
            const float rstd = rsqrtf(ss * (1.0f / 64.0f) + 1e-6f);
#pragma unroll
            for (int d0 = 0; d0 < 4; ++d0)
#pragma unroll
                for (int i = 0; i < 8; ++i) qf[d0][i] *= rstd * qgain[8 * (2 * d0 + hi) + i];
            const float* rp = ROPE + (size_t)qrow * 64;
            float qo[4][8];
#pragma unroll
            for (int d0 = 0; d0 < 2; ++d0)
#pragma unroll
                for (int i = 0; i < 8; ++i) { const int j = 8 * (2 * d0 + hi) + i; const float cs = rp[j], sn = rp[32 + j];
                    qo[d0][i] = qf[d0][i] * cs - qf[d0 + 2][i] * sn; qo[d0 + 2][i] = qf[d0][i] * sn + qf[d0 + 2][i] * cs; }
#pragma unroll
            for (int d0 = 0; d0 < 4; ++d0) { u32x4 pw; pw.x = pk2(qo[d0][0] * C2, qo[d0][1] * C2); pw.y = pk2(qo[d0][2] * C2, qo[d0][3] * C2); pw.z = pk2(qo[d0][4] * C2, qo[d0][5] * C2); pw.w = pk2(qo[d0][6] * C2, qo[d0][7] * C2);
                qr[d0] = __builtin_bit_cast(bf16x8, pw); }
        }
        float m_ref = sink[head] * 1.4426950408889634f; float l_run = hi ? 0.f : 1.f;
        f32x16 o0 = {}, o1 = {}; f32x16 negm;
#pragma unroll
        for (int r = 0; r < 16; ++r) negm[r] = -m_ref;
        u32x4 kreg, vreg, kreg2, vreg2, kreg3, vreg3;
#define TILE_K0(ti) (((ti) < 4) ? 64 * (ti) : q0 - 128 + 64 * (jlo + (ti) - 4))
#define LOAD_TILE(ti, kreg, vreg) do { const int k0_ = TILE_K0(ti); const size_t grow_ = ((ti) < 4) ? (size_t)(M_ + b * LCTX + k0_) : (size_t)(b * SEQ + k0_); \
        kreg = *(const u32x4*)(QKV + (grow_ + krow) * NQKV + 1024 + kvh * 64 + 8 * kch); vreg = *(const u32x4*)(QKV + (grow_ + lane) * NQKV + 1280 + kvh * 64 + 8 * w); } while (0)
#define STORE_TILE(buf, ti) do { *(LAS u32x4*)(L + (buf) * KBYTES + krow * KS + kch * 16) = kreg; \
        LAS unsigned short* vt_ = (LAS unsigned short*)(L + VOFF + (buf) * VBYTES + (8 * w) * VS + 2 * lane); \
        vt_[0 * (VS / 2)] = (unsigned short)(vreg.x & 0xffffu); vt_[1 * (VS / 2)] = (unsigned short)(vreg.x >> 16); vt_[2 * (VS / 2)] = (unsigned short)(vreg.y & 0xffffu); vt_[3 * (VS / 2)] = (unsigned short)(vreg.y >> 16); \
        vt_[4 * (VS / 2)] = (unsigned short)(vreg.z & 0xffffu); vt_[5 * (VS / 2)] = (unsigned short)(vreg.z >> 16); vt_[6 * (VS / 2)] = (unsigned short)(vreg.w & 0xffffu); vt_[7 * (VS / 2)] = (unsigned short)(vreg.w >> 16); } while (0)
        if (MODE & 1) { LOAD_TILE(0, kreg, vreg); STORE_TILE(0, 0); LOAD_TILE(1, kreg, vreg); LOAD_TILE(2, kreg2, vreg2); LOAD_TILE(3, kreg3, vreg3); } __syncthreads();
#pragma unroll 1
        for (int ti = 0; ti < ntiles; ++ti) {
            const int buf = ti & 1;
            if (MODE & 2) {
            f32x16 p0 = negm, p1 = negm;
            {
                const LAS unsigned char* kb = L + buf * KBYTES + r32 * KS + hi * 16;
#pragma unroll
                for (int d0 = 0; d0 < 4; ++d0) { const bf16x8 k0f = *(const LAS bf16x8*)(kb + d0 * 32); const bf16x8 k1f = *(const LAS bf16x8*)(kb + 32 * KS + d0 * 32);
                    p0 = __builtin_amdgcn_mfma_f32_32x32x16_bf16(k0f, qr[d0], p0, 0, 0, 0); p1 = __builtin_amdgcn_mfma_f32_32x32x16_bf16(k1f, qr[d0], p1, 0, 0, 0); }
            }
            if (ti >= 4 && (jlo + ti - 4 == 0 || jlo + ti - 4 == 4)) { const int k0 = TILE_K0(ti); const int dbase = qrow - k0 - 4 * hi;
#pragma unroll
                for (int r = 0; r < 16; ++r) { const int dq = dbase - ((r & 3) + 8 * (r >> 2)); if (dq > 128 || dq < -128) p0[r] = -INFINITY; const int dq1 = dq - 32; if (dq1 > 128 || dq1 < -128) p1[r] = -INFINITY; } }
            float mx = fmaxf(p0[0], p1[0]);
#pragma unroll
            for (int r = 1; r < 16; ++r) mx = fmaxf(mx, fmaxf(p0[r], p1[r]));
            mx = fmaxf(mx, __shfl_xor(mx, 32));
            if (__any(mx > 8.0f)) {
                const float dl = fmaxf(mx, 0.f); m_ref += dl; const float f = __builtin_amdgcn_exp2f(-dl); l_run *= f;
#pragma unroll
                for (int r = 0; r < 16; ++r) { p0[r] -= dl; p1[r] -= dl; o0[r] *= f; o1[r] *= f; negm[r] = -m_ref; }
            }
            float ls = 0.f;
#pragma unroll
            for (int r = 0; r < 16; ++r) { p0[r] = __builtin_amdgcn_exp2f(p0[r]); p1[r] = __builtin_amdgcn_exp2f(p1[r]); ls += p0[r] + p1[r]; }
            l_run += ls;
            bf16x8 pa[4];
            { u32x4 t0, t1, t2, t3;
              t0.x = pk2(p0[0], p0[1]); t0.y = pk2(p0[2], p0[3]); t0.z = pk2(p0[4], p0[5]); t0.w = pk2(p0[6], p0[7]);
              t1.x = pk2(p0[8], p0[9]); t1.y = pk2(p0[10], p0[11]); t1.z = pk2(p0[12], p0[13]); t1.w = pk2(p0[14], p0[15]);
              t2.x = pk2(p1[0], p1[1]); t2.y = pk2(p1[2], p1[3]); t2.z = pk2(p1[4], p1[5]); t2.w = pk2(p1[6], p1[7]);
              t3.x = pk2(p1[8], p1[9]); t3.y = pk2(p1[10], p1[11]); t3.z = pk2(p1[12], p1[13]); t3.w = pk2(p1[14], p1[15]);
              pa[0] = __builtin_bit_cast(bf16x8, t0); pa[1] = __builtin_bit_cast(bf16x8, t1); pa[2] = __builtin_bit_cast(bf16x8, t2); pa[3] = __builtin_bit_cast(bf16x8, t3); }
            {
                const LAS unsigned char* vb = L + VOFF + buf * VBYTES + r32 * VS + 8 * hi;
#pragma unroll
                for (int s = 0; s < 4; ++s) {
                    const s16x4 a0 = *(const LAS s16x4*)(vb + 32 * s), a1 = *(const LAS s16x4*)(vb + 32 * s + 16);
                    const s16x4 c0 = *(const LAS s16x4*)(vb + 32 * VS + 32 * s), c1 = *(const LAS s16x4*)(vb + 32 * VS + 32 * s + 16);
                    const bf16x8 va = (bf16x8){a0[0], a0[1], a0[2], a0[3], a1[0], a1[1], a1[2], a1[3]}, vc = (bf16x8){c0[0], c0[1], c0[2], c0[3], c1[0], c1[1], c1[2], c1[3]};
                    o0 = __builtin_amdgcn_mfma_f32_32x32x16_bf16(va, pa[s], o0, 0, 0, 0); o1 = __builtin_amdgcn_mfma_f32_32x32x16_bf16(vc, pa[s], o1, 0, 0, 0);
                }
            }
            }
            if (MODE & 1) { if (ti + 1 < ntiles) STORE_TILE(buf ^ 1, ti + 1);
            kreg = kreg2; vreg = vreg2; kreg2 = kreg3; vreg2 = vreg3;
            if (ti + 4 < ntiles) LOAD_TILE(ti + 4, kreg3, vreg3); }
            __syncthreads();
        }
#undef LOAD_TILE
#undef STORE_TILE
#undef TILE_K0
        if (MODE & 2) {
        const float lt = l_run + __shfl_xor(l_run, 32); const float inv = 1.0f / lt;
        bf16_t* op = OB + (size_t)(b * SEQ + qrow) * 1024 + head * 64 + 4 * hi;
#pragma unroll
        for (int g = 0; g < 4; ++g) {
            u32x2 w0, w1; w0.x = pk2(o0[4 * g] * inv, o0[4 * g + 1] * inv); w0.y = pk2(o0[4 * g + 2] * inv, o0[4 * g + 3] * inv);
            w1.x = pk2(o1[4 * g] * inv, o1[4 * g + 1] * inv); w1.y = pk2(o1[4 * g + 2] * inv, o1[4 * g + 3] * inv);
            *(u32x2*)(op + 8 * g) = w0; *(u32x2*)(op + 32 + 8 * g) = w1;
        }
        }
    }
}

template <int MODE = 3> __device__ __forceinline__ void attn_phase4(LAS unsigned char* L, const Args& a, int vcu, int G) {
    const int tid = threadIdx.x, lane = tid & 63, w = __builtin_amdgcn_readfirstlane(tid >> 6), r32 = lane & 31, hi = lane >> 5;
    constexpr int KS = 144, VS = 136, KBYTES = 64 * KS, VBYTES = 64 * VS, VOFF = 2 * KBYTES;
    const bf16_t* QKV = (const bf16_t*)(a.ws + WS_QKV); bf16_t* OB = (bf16_t*)(a.ws + WS_OB); const float* ROPE = (const float*)(a.ws + WS_ROPE);
    const float* qgain = a.in[10]; const float* sink = a.in[12];
    const float C2 = 0.125f * 1.4426950408889634f;
    const int krow = w * 8 + (lane >> 3), kch = lane & 7;
    u32x4 kreg, vreg, kreg2, vreg2, kreg3, vreg3;
#define LOAD_CTX(bq_, kvq_, tn_, kreg, vreg) do { const size_t grow_ = (size_t)(M_ + (bq_) * LCTX + 64 * (tn_)); \
        kreg = *(const u32x4*)(QKV + (grow_ + krow) * NQKV + 1024 + (kvq_) * 64 + 8 * kch); vreg = *(const u32x4*)(QKV + (grow_ + lane) * NQKV + 1280 + (kvq_) * 64 + 8 * w); } while (0)
    if (vcu < 4096) { const int b0_ = vcu >> 9, kv0_ = (vcu >> 7) & 3; LOAD_CTX(b0_, kv0_, 0, kreg, vreg); LOAD_CTX(b0_, kv0_, 1, kreg2, vreg2); LOAD_CTX(b0_, kv0_, 2, kreg3, vreg3); }
    u32x4 qraw[4]; f32x4 rcs[4], rsn[4];
#define Q_PREFETCH(u_) do { const int b_ = (u_) >> 9, kvh_ = ((u_) >> 7) & 3, q0_ = ((u_) & 127) * 64; const int head_ = kvh_ * 4 + (w & 3), qrow_ = q0_ + 32 * (w >> 2) + r32; \
        const bf16_t* qp_ = QKV + (size_t)(b_ * SEQ + qrow_) * NQKV + head_ * 64; const float* rp_ = ROPE + (size_t)qrow_ * 64; \
        _Pragma("unroll") for (int d0 = 0; d0 < 4; ++d0) qraw[d0] = *(const u32x4*)(qp_ + 8 * (2 * d0 + hi)); \
        _Pragma("unroll") for (int d0 = 0; d0 < 2; ++d0) { const int j_ = 8 * (2 * d0 + hi); rcs[2 * d0] = *(const f32x4*)(rp_ + j_); rcs[2 * d0 + 1] = *(const f32x4*)(rp_ + j_ + 4); \
            rsn[2 * d0] = *(const f32x4*)(rp_ + 32 + j_); rsn[2 * d0 + 1] = *(const f32x4*)(rp_ + 32 + j_ + 4); } } while (0)
    if (vcu < 4096) Q_PREFETCH(vcu);
    for (int unit = vcu; unit < 4096; unit += G) {
        const int b = unit >> 9, kvh = (unit >> 7) & 3, qb = unit & 127, q0 = qb * 64;
        const int head = kvh * 4 + (w & 3), qrow = q0 + 32 * (w >> 2) + r32;
        const int jlo = (q0 < 128) ? ((128 - q0) >> 6) : 0; const int jhi = (q0 > SEQ - 192) ? ((SEQ + 64 - q0) >> 6) : 4; const int ntiles = 4 + (jhi - jlo + 1);
        bf16x8 qr[4];
        {
            float qf[4][8]; float ss = 0.f;
#pragma unroll
            for (int d0 = 0; d0 < 4; ++d0) { const u32x4 v = qraw[d0];
                qf[d0][0] = bf_lo(v.x); qf[d0][1] = bf_hi(v.x); qf[d0][2] = bf_lo(v.y); qf[d0][3] = bf_hi(v.y); qf[d0][4] = bf_lo(v.z); qf[d0][5] = bf_hi(v.z); qf[d0][6] = bf_lo(v.w); qf[d0][7] = bf_hi(v.w);
#pragma unroll
                for (int i = 0; i < 8; ++i) ss += qf[d0][i] * qf[d0][i]; }
            ss += __shfl_xor(ss, 32);
            const float rstd = rsqrtf(ss * (1.0f / 64.0f) + 1e-6f);
#pragma unroll
            for (int d0 = 0; d0 < 4; ++d0) { const f32x4 g0 = *(const f32x4*)(qgain + 8 * (2 * d0 + hi)), g1 = *(const f32x4*)(qgain + 8 * (2 * d0 + hi) + 4);
#pragma unroll
                for (int i = 0; i < 4; ++i) { qf[d0][i] *= rstd * g0[i]; qf[d0][4 + i] *= rstd * g1[i]; } }
            float qo[4][8];
#pragma unroll
            for (int d0 = 0; d0 < 2; ++d0)
#pragma unroll
                for (int i = 0; i < 8; ++i) { const float cs = rcs[2 * d0 + (i >> 2)][i & 3], sn = rsn[2 * d0 + (i >> 2)][i & 3];
                    qo[d0][i] = qf[d0][i] * cs - qf[d0 + 2][i] * sn; qo[d0 + 2][i] = qf[d0][i] * sn + qf[d0 + 2][i] * cs; }
#pragma unroll
            for (int d0 = 0; d0 < 4; ++d0) { u32x4 pw; pw.x = pk2(qo[d0][0] * C2, qo[d0][1] * C2); pw.y = pk2(qo[d0][2] * C2, qo[d0][3] * C2); pw.z = pk2(qo[d0][4] * C2, qo[d0][5] * C2); pw.w = pk2(qo[d0][6] * C2, qo[d0][7] * C2);
                qr[d0] = __builtin_bit_cast(bf16x8, pw); }
        }
        if (unit + G < 4096) Q_PREFETCH(unit + G);
        float m_ref = sink[head] * 1.4426950408889634f; float l_run = hi ? 0.f : 1.f;
        f32x16 o0 = {}, o1 = {}; f32x16 negm;
#pragma unroll
        for (int r = 0; r < 16; ++r) negm[r] = -m_ref;
        const bool has_next = unit + G < 4096; const int bN = (unit + G) >> 9, kvN = ((unit + G) >> 7) & 3;
#define TILE_K0(ti) (((ti) < 4) ? 64 * (ti) : q0 - 128 + 64 * (jlo + (ti) - 4))
#define LOAD_TILE(ti, kreg, vreg) do { const int k0_ = TILE_K0(ti); const size_t grow_ = ((ti) < 4) ? (size_t)(M_ + b * LCTX + k0_) : (size_t)(b * SEQ + k0_); \
        kreg = *(const u32x4*)(QKV + (grow_ + krow) * NQKV + 1024 + kvh * 64 + 8 * kch); vreg = *(const u32x4*)(QKV + (grow_ + lane) * NQKV + 1280 + kvh * 64 + 8 * w); } while (0)
#define STORE_TILE(kbuf, vbuf) do { *(LAS u32x4*)(L + (kbuf) * KBYTES + krow * KS + kch * 16) = kreg; \
        LAS unsigned short* vt_ = (LAS unsigned short*)(L + VOFF + (vbuf) * VBYTES + (8 * w) * VS + 2 * lane); \
        vt_[0 * (VS / 2)] = (unsigned short)(vreg.x & 0xffffu); vt_[1 * (VS / 2)] = (unsigned short)(vreg.x >> 16); vt_[2 * (VS / 2)] = (unsigned short)(vreg.y & 0xffffu); vt_[3 * (VS / 2)] = (unsigned short)(vreg.y >> 16); \
        vt_[4 * (VS / 2)] = (unsigned short)(vreg.z & 0xffffu); vt_[5 * (VS / 2)] = (unsigned short)(vreg.z >> 16); vt_[6 * (VS / 2)] = (unsigned short)(vreg.w & 0xffffu); vt_[7 * (VS / 2)] = (unsigned short)(vreg.w >> 16); } while (0)
#define QK_MAX(ti, kbuf) \
        f32x16 p0 = negm, p1 = negm; \
        { const LAS unsigned char* kb_ = L + (kbuf) * KBYTES + r32 * KS + hi * 16; \
          _Pragma("unroll") for (int d0 = 0; d0 < 4; ++d0) { const bf16x8 k0f = *(const LAS bf16x8*)(kb_ + d0 * 32); const bf16x8 k1f = *(const LAS bf16x8*)(kb_ + 32 * KS + d0 * 32); \
            p0 = __builtin_amdgcn_mfma_f32_32x32x16_bf16(k0f, qr[d0], p0, 0, 0, 0); p1 = __builtin_amdgcn_mfma_f32_32x32x16_bf16(k1f, qr[d0], p1, 0, 0, 0); } } \
        if ((ti) >= 4 && (jlo + (ti) - 4 == 0 || jlo + (ti) - 4 == 4)) { const int k0_ = TILE_K0(ti); const int dbase = qrow - k0_ - 4 * hi; \
          _Pragma("unroll") for (int r = 0; r < 16; ++r) { const int dq = dbase - ((r & 3) + 8 * (r >> 2)); if (dq > 128 || dq < -128) p0[r] = -INFINITY; const int dq1 = dq - 32; if (dq1 > 128 || dq1 < -128) p1[r] = -INFINITY; } } \
        float mx = fmaxf(p0[0], p1[0]); \
        _Pragma("unroll") for (int r = 1; r < 16; ++r) mx = fmaxf(mx, fmaxf(p0[r], p1[r])); \
        mx = fmaxf(mx, __shfl_xor(mx, 32)); \
        const bool resc = __any(mx > 8.0f); float fres = 1.0f; \
        if (resc) { const float dl = fmaxf(mx, 0.f); m_ref += dl; fres = __builtin_amdgcn_exp2f(-dl); l_run *= fres; \
          _Pragma("unroll") for (int r = 0; r < 16; ++r) { p0[r] -= dl; p1[r] -= dl; negm[r] = -m_ref; } }
#define EXP_PACK() do { float ls = 0.f; \
        _Pragma("unroll") for (int r = 0; r < 16; ++r) { p0[r] = __builtin_amdgcn_exp2f(p0[r]); p1[r] = __builtin_amdgcn_exp2f(p1[r]); ls += p0[r] + p1[r]; } \
        l_run += ls; \
        { u32x4 t0, t1, t2, t3; \
          t0.x = pk2(p0[0], p0[1]); t0.y = pk2(p0[2], p0[3]); t0.z = pk2(p0[4], p0[5]); t0.w = pk2(p0[6], p0[7]); \
          t1.x = pk2(p0[8], p0[9]); t1.y = pk2(p0[10], p0[11]); t1.z = pk2(p0[12], p0[13]); t1.w = pk2(p0[14], p0[15]); \
          t2.x = pk2(p1[0], p1[1]); t2.y = pk2(p1[2], p1[3]); t2.z = pk2(p1[4], p1[5]); t2.w = pk2(p1[6], p1[7]); \
          t3.x = pk2(p1[8], p1[9]); t3.y = pk2(p1[10], p1[11]); t3.z = pk2(p1[12], p1[13]); t3.w = pk2(p1[14], p1[15]); \
          pa[0] = __builtin_bit_cast(bf16x8, t0); pa[1] = __builtin_bit_cast(bf16x8, t1); pa[2] = __builtin_bit_cast(bf16x8, t2); pa[3] = __builtin_bit_cast(bf16x8, t3); } } while (0)
#define PV_TILE(vbuf) do { const LAS unsigned char* vb_ = L + VOFF + (vbuf) * VBYTES + r32 * VS + 8 * hi; \
        _Pragma("unroll") for (int s = 0; s < 4; ++s) { \
            const s16x4 a0 = *(const LAS s16x4*)(vb_ + 32 * s), a1 = *(const LAS s16x4*)(vb_ + 32 * s + 16); \
            const s16x4 c0 = *(const LAS s16x4*)(vb_ + 32 * VS + 32 * s), c1 = *(const LAS s16x4*)(vb_ + 32 * VS + 32 * s + 16); \
            const bf16x8 va = (bf16x8){a0[0], a0[1], a0[2], a0[3], a1[0], a1[1], a1[2], a1[3]}, vc = (bf16x8){c0[0], c0[1], c0[2], c0[3], c1[0], c1[1], c1[2], c1[3]}; \
            o0 = __builtin_amdgcn_mfma_f32_32x32x16_bf16(va, pa[s], o0, 0, 0, 0); o1 = __builtin_amdgcn_mfma_f32_32x32x16_bf16(vc, pa[s], o1, 0, 0, 0); } } while (0)
#define STAGE_NEXT(ti, vnext) do { if ((ti) + 1 < ntiles) { STORE_TILE(((ti) + 1) & 1, vnext); \
        kreg = kreg2; vreg = vreg2; kreg2 = kreg3; vreg2 = vreg3; \
        if ((ti) + 4 < ntiles) LOAD_TILE((ti) + 4, kreg3, vreg3); else if (has_next) LOAD_CTX(bN, kvN, (ti) + 4 - ntiles, kreg3, vreg3); } } while (0)
        bf16x8 pa[4];
        STORE_TILE(0, 0); kreg = kreg2; vreg = vreg2; kreg2 = kreg3; vreg2 = vreg3; LOAD_TILE(3, kreg3, vreg3); __syncthreads();
        {
            QK_MAX(0, 0)
            EXP_PACK();
            if (resc) { _Pragma("unroll") for (int r = 0; r < 16; ++r) { o0[r] *= fres; o1[r] *= fres; } }
            STAGE_NEXT(0, 1);
            __syncthreads();
        }
        int vprev = 0, vcur = 1;
#pragma unroll 1
        for (int ti = 1; ti < ntiles; ++ti) {
            const int vnext = (vcur == 2) ? 0 : vcur + 1;
            QK_MAX(ti, ti & 1)
            PV_TILE(vprev);
            EXP_PACK();
#pragma unroll
            for (int i_ = 0; i_ < 8; ++i_) { __builtin_amdgcn_sched_group_barrier(0x008, 1, 0); __builtin_amdgcn_sched_group_barrier(0x002, 11, 0); }
            if (resc) { _Pragma("unroll") for (int r = 0; r < 16; ++r) { o0[r] *= fres; o1[r] *= fres; } }
            STAGE_NEXT(ti, vnext);
            vprev = vcur; vcur = vnext;
            __syncthreads();
        }
        PV_TILE(vprev);
        __syncthreads();
#undef LOAD_TILE
#undef STORE_TILE
#undef TILE_K0
#undef QK_MAX
#undef EXP_PACK
#undef PV_TILE
#undef STAGE_NEXT
#undef Q_PREFETCH
#undef LOAD_CTX
        if (MODE & 2) {
        const float lt = l_run + __shfl_xor(l_run, 32); const float inv = 1.0f / lt;
        bf16_t* op = OB + (size_t)(b * SEQ + qrow) * 1024 + head * 64 + 4 * hi;
#pragma unroll
        for (int g = 0; g < 4; ++g) {
            u32x2 w0, w1; w0.x = pk2(o0[4 * g] * inv, o0[4 * g + 1] * inv); w0.y = pk2(o0[4 * g + 2] * inv, o0[4 * g + 3] * inv);
            w1.x = pk2(o1[4 * g] * inv, o1[4 * g + 1] * inv); w1.y = pk2(o1[4 * g + 2] * inv, o1[4 * g + 3] * inv);
            *(u32x2*)(op + 8 * g) = w0; *(u32x2*)(op + 32 + 8 * g) = w1;
        }
        }
    }
}

__device__ __forceinline__ void conv3(const unsigned* zp, int dw, float w0, float w1, float w2, float cb, float& o0, float& o1) {
    const unsigned cur = zp[dw]; const unsigned prev = dw > 0 ? zp[dw - 1] : 0u; const unsigned next = dw < SEQ / 2 - 1 ? zp[dw + 1] : 0u;
    const float zm1 = bf_hi(prev), z0 = bf_lo(cur), z1 = bf_hi(cur), z2 = bf_lo(next);
    o0 = w0 * zm1 + w1 * z0 + w2 * z1 + cb; o1 = w0 * z0 + w1 * z1 + w2 * z2 + cb;
}
__device__ __forceinline__ void conv8(const unsigned* zp, int cidx, float w0, float w1, float w2, float cb, float (&o)[8]) {
    const u32x4 cur = *(const u32x4*)(zp + 4 * cidx); const unsigned prev = cidx > 0 ? zp[4 * cidx - 1] : 0u; const unsigned next = cidx < SEQ / 8 - 1 ? zp[4 * cidx + 4] : 0u;
    const float zz[10] = {bf_hi(prev), bf_lo(cur.x), bf_hi(cur.x), bf_lo(cur.y), bf_hi(cur.y), bf_lo(cur.z), bf_hi(cur.z), bf_lo(cur.w), bf_hi(cur.w), bf_lo(next)};
#pragma unroll
    for (int e = 0; e < 8; ++e) o[e] = w0 * zz[e] + w1 * zz[e + 1] + w2 * zz[e + 2] + cb;
}
struct Raw8 { u32x4 cur; unsigned prev, next; };
__device__ __forceinline__ Raw8 raw8_load(const unsigned* zp, int cidx) { Raw8 r; r.cur = *(const u32x4*)(zp + 4 * cidx); r.prev = cidx > 0 ? zp[4 * cidx - 1] : 0u; r.next = cidx < SEQ / 8 - 1 ? zp[4 * cidx + 4] : 0u; return r; }
__device__ __forceinline__ void conv8_raw(const Raw8& r, float w0, float w1, float w2, float cb, float (&o)[8]) {
    const float zz[10] = {bf_hi(r.prev), bf_lo(r.cur.x), bf_hi(r.cur.x), bf_lo(r.cur.y), bf_hi(r.cur.y), bf_lo(r.cur.z), bf_hi(r.cur.z), bf_lo(r.cur.w), bf_hi(r.cur.w), bf_lo(r.next)};
#pragma unroll
    for (int e = 0; e < 8; ++e) o[e] = w0 * zz[e] + w1 * zz[e + 1] + w2 * zz[e + 2] + cb;
}
__device__ __forceinline__ void hyena_phase(LAS unsigned char* L, const Args& a, int vcu, int G) {
    const int tid = threadIdx.x;
    LAS cf* z = (LAS cf*)L; LAS cf* Thi = (LAS cf*)(L + 131072); LAS cf* Tlo = Thi + 128;
    const bf16_t* ZT = (const bf16_t*)(a.ws + WS_ZT); bf16_t* Gc = (bf16_t*)(a.ws + WS_G);
    const f32x4* SD = (const f32x4*)(a.ws + WS_SD); const f32x4* SD8 = (const f32x4*)(a.ws + WS_SD8);
    const float* cw = a.in[15]; const float* cb = a.in[16]; const float* skip = a.in[25];
    fft_tables(Thi, Tlo, tid);
    Raw8 nx1a[2], nx1b[2], nxva[2], nxvb[2];
#define HY_PREFETCH(u_) do { const int b_ = (u_) & 7, ca_ = 2 * ((u_) >> 3); \
        const unsigned* q1a = (const unsigned*)(ZT + (size_t)(D_ + ca_) * ZLD + (size_t)b_ * SEQ); const unsigned* q1b = (const unsigned*)(ZT + (size_t)(D_ + ca_ + 1) * ZLD + (size_t)b_ * SEQ); \
        const unsigned* qva = (const unsigned*)(ZT + (size_t)(2 * D_ + ca_) * ZLD + (size_t)b_ * SEQ); const unsigned* qvb = (const unsigned*)(ZT + (size_t)(2 * D_ + ca_ + 1) * ZLD + (size_t)b_ * SEQ); \
        _Pragma("unroll") for (int i = 0; i < 2; ++i) { const int cidx = tid + 512 * i; nx1a[i] = raw8_load(q1a, cidx); nx1b[i] = raw8_load(q1b, cidx); nxva[i] = raw8_load(qva, cidx); nxvb[i] = raw8_load(qvb, cidx); } } while (0)
    if (vcu < 4096) HY_PREFETCH(vcu);
    for (int unit = vcu; unit < 4096; unit += G) {
        const int b = unit & 7, pair = unit >> 3, ca = 2 * pair;
        float ua[2][8], ub[2][8];
        {
            const int r1a = D_ + ca, r1b = r1a + 1, rva = 2 * D_ + ca, rvb = rva + 1;
            const float w1a0 = cw[r1a], w1a1 = cw[3072 + r1a], w1a2 = cw[6144 + r1a], c1a = cb[r1a];
            const float w1b0 = cw[r1b], w1b1 = cw[3072 + r1b], w1b2 = cw[6144 + r1b], c1b = cb[r1b];
            const float wva0 = cw[rva], wva1 = cw[3072 + rva], wva2 = cw[6144 + rva], cva = cb[rva];
            const float wvb0 = cw[rvb], wvb1 = cw[3072 + rvb], wvb2 = cw[6144 + rvb], cvb = cb[rvb];
#pragma unroll
            for (int i = 0; i < 2; ++i) { const int cidx = tid + 512 * i;
                float x1[8], vv[8];
                conv8_raw(nx1a[i], w1a0, w1a1, w1a2, c1a, x1); conv8_raw(nxva[i], wva0, wva1, wva2, cva, vv);
#pragma unroll
                for (int e = 0; e < 8; ++e) ua[i][e] = vv[e] * x1[e];
                conv8_raw(nx1b[i], w1b0, w1b1, w1b2, c1b, x1); conv8_raw(nxvb[i], wvb0, wvb1, wvb2, cvb, vv);
#pragma unroll
                for (int e = 0; e < 8; ++e) ub[i][e] = vv[e] * x1[e];
#pragma unroll
                for (int e = 0; e < 8; e += 2) *(LAS f32x4*)(z + PH(8 * cidx + e)) = (f32x4){ua[i][e], ub[i][e], ua[i][e + 1], ub[i][e + 1]};
            }
        }
        __syncthreads();
        fft_pass16<false, 10, true>(z, Thi, Tlo, tid); fft_pass16<false, 6>(z, Thi, Tlo, tid); fft_pass16<false, 2>(z, Thi, Tlo, tid);
        f32x4 sd[16];
        {
            const f32x4* sdp = SD + (size_t)pair * 8192;
#pragma unroll
            for (int i = 0; i < 16; ++i) sd[i] = sdp[2 * (tid + 512 * (i >> 1)) + (i & 1)];
        }
        fft_pass4<false>(z, tid);
        {
#pragma unroll
            for (int i = 0; i < 8; ++i) {
                const int g = tid + 512 * i;
                const int kg = (g >> 8) | (((g >> 4) & 15) << 4) | ((g & 15) << 8);
                const int pp0 = p_of_k((NFFT - kg) & (NFFT - 1)), pp1 = p_of_k(12288 - kg);
                const int p0 = PH(4 * g);
                const f32x4 zz = *(LAS f32x4*)(z + p0);
                const cf zk0 = {zz[0], zz[1]}, zk1 = {zz[2], zz[3]};
                const cf zn0 = z[PH(pp0)], zn1 = z[PH(pp1)];
                const f32x4 s0 = sd[2 * i], s1 = sd[2 * i + 1];
                const cf S0 = {s0[0], s0[1]}, D0 = {s0[2], s0[3]}, S1 = {s1[0], s1[1]}, D1 = {s1[2], s1[3]};
                const cf w0 = cmul(zk0, S0) + cmul(cconj(zn0), D0), w1 = cmul(zk1, S1) + cmul(cconj(zn1), D1);
                *(LAS f32x4*)(z + p0) = (f32x4){w0.x, w0.y, w1.x, w1.y};
                if (kg != 0) z[PH(pp0)] = cmulc(zn0, S0) + cconj(cmul(zk0, D0));
                z[PH(pp1)] = cmulc(zn1, S1) + cconj(cmul(zk1, D1));
            }
            if (tid == 0) { const f32x4 s8 = SD8[pair]; const cf S = {s8[0], s8[1]}, Dd = {s8[2], s8[3]}; const cf zk = z[PH(2)]; z[PH(2)] = cmul(zk, S) + cmul(cconj(zk), Dd); }
        }
        __syncthreads();
        fft_pass4<true>(z, tid); fft_pass16<true, 2>(z, Thi, Tlo, tid); fft_pass16<true, 6>(z, Thi, Tlo, tid);
        float xa[2][8], xb[2][8];
        {
            const int r0a = ca, r0b = ca + 1;
            const float wa0 = cw[r0a], wa1 = cw[3072 + r0a], wa2 = cw[6144 + r0a], c0a = cb[r0a];
            const float wb0 = cw[r0b], wb1 = cw[3072 + r0b], wb2 = cw[6144 + r0b], c0b = cb[r0b];
            const unsigned* p0a = (const unsigned*)(ZT + (size_t)r0a * ZLD + (size_t)b * SEQ); const unsigned* p0b = (const unsigned*)(ZT + (size_t)r0b * ZLD + (size_t)b * SEQ);
#pragma unroll
            for (int i = 0; i < 2; ++i) { const int cidx = tid + 512 * i; conv8(p0a, cidx, wa0, wa1, wa2, c0a, xa[i]); conv8(p0b, cidx, wb0, wb1, wb2, c0b, xb[i]); }
        }
        if (unit + G < 4096) HY_PREFETCH(unit + G);
        fft_pass16<true, 10, true>(z, Thi, Tlo, tid);
        {
            const float ska = skip[ca], skb = skip[ca + 1];
            u32x4* ga = (u32x4*)(Gc + (size_t)ca * GLD + (size_t)b * SEQ); u32x4* gb = (u32x4*)(Gc + (size_t)(ca + 1) * GLD + (size_t)b * SEQ);
#pragma unroll
            for (int i = 0; i < 2; ++i) { const int cidx = tid + 512 * i;
                float ya[8], yb[8];
#pragma unroll
                for (int e = 0; e < 8; e += 2) { const f32x4 y = *(LAS f32x4*)(z + PH(8 * cidx + e)); ya[e] = y[0]; yb[e] = y[1]; ya[e + 1] = y[2]; yb[e + 1] = y[3]; }
                u32x4 oa, ob;
                oa.x = pk2((ya[0] + ua[i][0] * ska) * xa[i][0], (ya[1] + ua[i][1] * ska) * xa[i][1]); oa.y = pk2((ya[2] + ua[i][2] * ska) * xa[i][2], (ya[3] + ua[i][3] * ska) * xa[i][3]);
                oa.z = pk2((ya[4] + ua[i][4] * ska) * xa[i][4], (ya[5] + ua[i][5] * ska) * xa[i][5]); oa.w = pk2((ya[6] + ua[i][6] * ska) * xa[i][6], (ya[7] + ua[i][7] * ska) * xa[i][7]);
                ob.x = pk2((yb[0] + ub[i][0] * skb) * xb[i][0], (yb[1] + ub[i][1] * skb) * xb[i][1]); ob.y = pk2((yb[2] + ub[i][2] * skb) * xb[i][2], (yb[3] + ub[i][3] * skb) * xb[i][3]);
                ob.z = pk2((yb[4] + ub[i][4] * skb) * xb[i][4], (yb[5] + ub[i][5] * skb) * xb[i][5]); ob.w = pk2((yb[6] + ub[i][6] * skb) * xb[i][6], (yb[7] + ub[i][7] * skb) * xb[i][7]);
                ga[cidx] = oa; gb[cidx] = ob; }
        }
        __syncthreads();
    }
}

#undef HY_PREFETCH
__device__ __forceinline__ void transpose_phase(LAS unsigned char* L, const Args& a) {
    const int tid = threadIdx.x, lane = tid & 63, w = tid >> 6; const int gw = blockIdx.x * 8 + w, NGW = gridDim.x * 8;
    const bf16_t* Gc = (const bf16_t*)(a.ws + WS_G); bf16_t* GT = (bf16_t*)(a.ws + WS_GT);
    LAS unsigned char* T = L + w * 16384;
    u32x4 nx[8];
#define TP_LOAD(item_) do { const int c0_ = ((item_) & 15) * 64, t0_ = ((item_) >> 4) * 64; \
        _Pragma("unroll") for (int j = 0; j < 8; ++j) nx[j] = *(const u32x4*)(Gc + (size_t)(c0_ + 8 * j + (lane >> 3)) * GLD + t0_ + 8 * (lane & 7)); } while (0)
    if (gw < 16 * 1024) TP_LOAD(gw);
    for (int item = gw; item < 16 * 1024; item += NGW) {
        const int cblk = item & 15, tblk = item >> 4; const int c0 = cblk * 64, t0 = tblk * 64;
#pragma unroll
        for (int j = 0; j < 8; ++j) { const int c = 8 * j + (lane >> 3), ch = lane & 7; const u32x4 v = nx[j];
            LAS unsigned* d = (LAS unsigned*)(T + c * 132 + ch * 16); d[0] = v.x; d[1] = v.y; d[2] = v.z; d[3] = v.w; }
        if (item + NGW < 16 * 1024) TP_LOAD(item + NGW);
        asm volatile("s_waitcnt lgkmcnt(0)" ::: "memory");
#pragma unroll
        for (int j = 0; j < 8; ++j) { const int t = 8 * j + (lane >> 3), ch = lane & 7; const LAS unsigned short* s = (const LAS unsigned short*)(T + (8 * ch) * 132 + 2 * t);
            u32x4 o; o.x = (unsigned)s[0] | ((unsigned)s[66] << 16); o.y = (unsigned)s[132] | ((unsigned)s[198] << 16); o.z = (unsigned)s[264] | ((unsigned)s[330] << 16); o.w = (unsigned)s[396] | ((unsigned)s[462] << 16);
            *(u32x4*)(GT + (size_t)(t0 + t) * 1024 + c0 + 8 * ch) = o; }
        asm volatile("s_waitcnt lgkmcnt(0)" ::: "memory");
    }
#undef TP_LOAD
}

#define XB_TMO      128
#define XB_XCNT(j)  (256  + 64 * (j))
#define XB_XSUB(j)  (1280 + 64 * (j))
#define XB_XGEN(j)  (2304 + 64 * (j))
#define XB_TOP      3328
#define XB_TOPGEN   3392
#define XCD_BAR_WORDS 3456
#define XB_SPIN_CAP (1u << 18)

__device__ __forceinline__ unsigned xb_ld(unsigned* p)              { return __hip_atomic_load(p, __ATOMIC_RELAXED, __HIP_MEMORY_SCOPE_AGENT); }
__device__ __forceinline__ unsigned xb_add(unsigned* p, unsigned v) { return __hip_atomic_fetch_add(p, v, __ATOMIC_RELAXED, __HIP_MEMORY_SCOPE_AGENT); }
__device__ __forceinline__ unsigned xb_xcc_id() { return (unsigned)__builtin_amdgcn_s_getreg((3 << 11) | 20) & 0xFu; }
#define XB_SPIN(cond, bar) do { unsigned _sp = 0; while (cond) { __builtin_amdgcn_s_sleep(1); \
    if ((++_sp & 255u) == 0u) { if (xb_ld(&(bar)[XB_TMO])) break; if (_sp > XB_SPIN_CAP) { atomicAdd(&(bar)[XB_TMO], 1u); break; } } } } while (0)

struct XcdBarrier {
    unsigned* bar; unsigned x;
    volatile LAS unsigned* st;
};

__device__ __forceinline__ XcdBarrier xcd_barrier_post(unsigned* bar, volatile LAS unsigned* st) {
    XcdBarrier b; b.bar = bar; b.x = xb_xcc_id(); b.st = st;
    if (threadIdx.x == 0) (void)xb_add(&bar[XB_XCNT(b.x)], 1u);
    return b;
}
__device__ __forceinline__ void xcd_barrier_complete(unsigned* bar, unsigned x, unsigned& nloc, unsigned& nx) {
    const unsigned G = gridDim.x * gridDim.y * gridDim.z;
    unsigned sum, cnt, mine, sp = 0u;
    for (;;) {
        sum = 0u; cnt = 0u; mine = 0u;
#pragma unroll
        for (unsigned j = 0; j < 16; ++j) { const unsigned c = xb_ld(&bar[XB_XCNT(j)]); sum += c; cnt += (c > 0u) ? 1u : 0u; mine = (j == x) ? c : mine; }
        if (sum == G) break;
        __builtin_amdgcn_s_sleep(1);
        if ((++sp & 255u) == 0u) { if (xb_ld(&bar[XB_TMO])) break; if (sp > XB_SPIN_CAP) { atomicAdd(&bar[XB_TMO], 1u); break; } }
    }
    nloc = mine > 0u ? mine : 1u; nx = cnt > 0u ? cnt : 1u;
}

__device__ __forceinline__ void xcd_barrier(const XcdBarrier& b) {
    asm volatile("s_waitcnt vmcnt(0)" ::: "memory");
    __syncthreads();
    if (threadIdx.x == 0) {
        unsigned* bar = b.bar;
        __builtin_amdgcn_s_waitcnt(0);
        unsigned nloc = b.st[0], nx = b.st[1];
        if (nloc == 0u) { xcd_barrier_complete(bar, b.x, nloc, nx); b.st[0] = nloc; b.st[1] = nx; }
        const unsigned old = xb_add(&bar[XB_XSUB(b.x)], 1u);
        const unsigned gen = old / nloc;
        if (old + 1u == (gen + 1u) * nloc) {
            __builtin_amdgcn_fence(__ATOMIC_RELEASE, "agent");
            asm volatile("s_waitcnt vmcnt(0)" ::: "memory");
            const unsigned og = xb_add(&bar[XB_TOP], 1u);
            const unsigned tg = og / nx;
            if (og + 1u == (tg + 1u) * nx) xb_add(&bar[XB_TOPGEN], 1u);
            else XB_SPIN(xb_ld(&bar[XB_TOPGEN]) == tg, bar);
            __builtin_amdgcn_fence(__ATOMIC_ACQUIRE, "agent");
            xb_add(&bar[XB_XGEN(b.x)], 1u);
            asm volatile("s_waitcnt vmcnt(0)" ::: "memory");
        } else {
            XB_SPIN(xb_ld(&bar[XB_XGEN(b.x)]) == gen, bar);
            __builtin_amdgcn_fence(__ATOMIC_ACQUIRE, "agent");
            asm volatile("s_waitcnt vmcnt(0)" ::: "memory");
        }
    }
    __syncthreads();
}

struct Group6Order : pg8::StaticOrder {
    __device__ bool next(int i, pg8::Unit& u) const {
        const long Lq = (long)i * G + c; if (Lq >= nwg) return false;
        int wgid = (int)Lq; { const int q = nwg / pg8::NXCD, r = nwg % pg8::NXCD, xcd = wgid % pg8::NXCD, off = wgid / pg8::NXCD; wgid = (xcd < r ? xcd * (q + 1) : r * (q + 1) + (xcd - r) * q) + off; }
        constexpr int W6 = 6; const int nig = W6 * nN, gid = wgid / nig, fm = gid * W6, gsz = (nM - fm) < W6 ? (nM - fm) : W6;
        u.pm = fm + ((wgid % nig) % gsz); u.pn = (wgid % nig) / gsz; return true;
    }
};
__global__ void __launch_bounds__(512, 2) fwd_megakernel(Args a) {
    extern __shared__ __attribute__((aligned(16))) unsigned char lds_raw[];
    LAS unsigned char* L = (LAS unsigned char*)lds_raw;
    const int G = gridDim.x, bx = blockIdx.x; const int vcu = (G % 8 == 0) ? (bx % 8) * (G / 8) + bx / 8 : bx;
    unsigned char* ws = a.ws;
    const float* MOD0 = (const float*)(ws + WS_MOD); const float* MOD1 = MOD0 + 9 * 6144;
    bf16_t* XN = (bf16_t*)(ws + WS_XN);
    const int lo = a.ph_lo, hi = a.ph_hi;
    volatile LAS unsigned* xst = (volatile LAS unsigned*)(L + LDS_BYTES - 64);
    if (threadIdx.x < 16) xst[threadIdx.x] = 0u;
    __syncthreads();
    XcdBarrier xbar; xbar.bar = (unsigned*)(ws + WS_BAR); xbar.x = 0; xbar.st = nullptr;
    if (hi - lo > 1) xbar = xcd_barrier_post((unsigned*)(ws + WS_BAR), xst);
#ifndef PHMASK
#define PHMASK 0x1ffff
#endif
#define IN(k) ((((PHMASK) >> (k)) & 1) && lo <= (k) && (k) < hi)
#define SEAM(k) do { if (IN(k) && IN((k) + 1)) { if ((k) == 0) cg::this_grid().sync(); else xcd_barrier(xbar); } } while (0)
#ifndef REPMASK
#define REPMASK 0
#endif
#define REP(k) for (int rep_ = 0; rep_ < ((((REPMASK) >> (k)) & 1) ? 2 : 1); ++rep_, (((REPMASK) >> (k)) & 1) ? cg::this_grid().sync() : (void)0)
#ifdef SYNC_PROBE
    if (lo == 0 && hi == NPHASE) { for (int q_ = 0; q_ < SYNC_PROBE; ++q_) cg::this_grid().sync(); }
#endif
#ifndef P0_PROBE
#define P0_PROBE 15
#endif
    if (IN(0)) REP(0) { if (rep_ == 0 && (REPMASK & 1)) phase0<P0_PROBE>(L, a); else phase0<15>(L, a); } SEAM(0);
#ifndef P1_PROBE
#define P1_PROBE 3
#endif
    if (IN(1)) REP(1) { const int sub_ = (rep_ == 0 && (REPMASK & 2)) ? P1_PROBE : 3; if (sub_ & 1) filter_phase(L, a); if (sub_ & 2) norm_phase(a, a.in[0], 0, 0, true); } SEAM(1);
    if (IN(2)) REP(2) { pg8::Gemm g{XN, (const bf16_t*)(ws + WS_WQKV), MT_, NQKV, 1024}; pg8::StaticOrder S; S.init(MT_, NQKV, G, bx);
        pg8::EpiStoreBf16 E{(bf16_t*)(ws + WS_QKV), (size_t)NQKV, nullptr}; pg8::gemm_phase<pg8::EpiStoreBf16, pg8::StaticOrder, true, true>(L, g, S, E); } SEAM(2);
    if (IN(3)) REP(3) { kprep_phase(a); } SEAM(3);
#ifndef ATTN_PROBE
#define ATTN_PROBE 3
#endif
    if (IN(4)) REP(4) { attn_phase4<3>(L, a, vcu, G); } SEAM(4);
    if (IN(5)) REP(5) { pg8::Gemm g{(const bf16_t*)(ws + WS_OB), (const bf16_t*)(ws + WS_WO), M_, 1024, 1024}; pg8::StaticOrder S; S.init(M_, 1024, G, bx);
        pg8::EpiResid<false, true> E{a.in[0], ws + WS_XS, MOD0 + 2 * 1024, nullptr}; pg8::gemm_phase<pg8::EpiResid<false, true>, pg8::StaticOrder, true, true>(L, g, S, E); } SEAM(5);
    if (IN(6)) REP(6) { norm_phase_bf16(a, 0, 1); } SEAM(6);
    if (IN(7)) REP(7) { pg8::Gemm g{XN, (const bf16_t*)(ws + WS_WFF1), M_, NFF1, 1024}; pg8::StaticOrder S; S.init(M_, NFF1, G, bx);
        pg8::EpiSwiGLU E{(bf16_t*)(ws + WS_H), DFF}; pg8::gemm_phase<pg8::EpiSwiGLU, pg8::StaticOrder, true, true>(L, g, S, E); } SEAM(7);
    if (IN(8)) REP(8) { pg8::Gemm g{(const bf16_t*)(ws + WS_H), (const bf16_t*)(ws + WS_WFF2), M_, 1024, DFF}; pg8::StaticOrder S; S.init(M_, 1024, G, bx);
        pg8::EpiResid<true, true> E{ws + WS_XS, ws + WS_XS, MOD0 + 5 * 1024, nullptr}; pg8::gemm_phase<pg8::EpiResid<true, true>, pg8::StaticOrder, true, true>(L, g, S, E); } SEAM(8);
    if (IN(9)) REP(9) { norm_phase_bf16(a, 1, 0); } SEAM(9);
    if (IN(10)) REP(10) { pg8::Gemm g{(const bf16_t*)(ws + WS_WIN), XN, 3072, M_, 1024}; Group6Order S; S.init(3072, M_, G, bx);
        pg8::EpiStoreBf16 E{(bf16_t*)(ws + WS_ZT), ZLD, a.in[14]}; pg8::gemm_phase<pg8::EpiStoreBf16, Group6Order, true, true>(L, g, S, E); } SEAM(10);
    if (IN(11)) REP(11) { hyena_phase(L, a, vcu, G); } SEAM(11);
    if (IN(12)) REP(12) { transpose_phase(L, a); } SEAM(12);
    if (IN(13)) REP(13) { pg8::Gemm g{(const bf16_t*)(ws + WS_GT), (const bf16_t*)(ws + WS_WOUT), M_, 1024, 1024}; pg8::StaticOrder S; S.init(M_, 1024, G, bx);
        pg8::EpiResid<true, true> E{ws + WS_XS, ws + WS_XS, MOD1 + 2 * 1024, a.in[27]}; pg8::gemm_phase<pg8::EpiResid<true, true>, pg8::StaticOrder, true, true>(L, g, S, E); } SEAM(13);
    if (IN(14)) REP(14) { norm_phase_bf16(a, 1, 1); } SEAM(14);
    if (IN(15)) REP(15) { pg8::Gemm g{XN, (const bf16_t*)(ws + WS_WFF1 + 11 * MiB), M_, NFF1, 1024}; pg8::StaticOrder S; S.init(M_, NFF1, G, bx);
        pg8::EpiSwiGLU E{(bf16_t*)(ws + WS_H), DFF}; pg8::gemm_phase<pg8::EpiSwiGLU, pg8::StaticOrder, true, true>(L, g, S, E); } SEAM(15);
    if (IN(16)) REP(16) { pg8::Gemm g{(const bf16_t*)(ws + WS_H), (const bf16_t*)(ws + WS_WFF2 + 6 * MiB), M_, 1024, DFF}; pg8::StaticOrder S; S.init(M_, 1024, G, bx);
        pg8::EpiResid<true, false> E{ws + WS_XS, a.out, MOD1 + 5 * 1024, nullptr}; pg8::gemm_phase<pg8::EpiResid<true, false>, pg8::StaticOrder, true, true>(L, g, S, E); }
#undef IN
#undef SEAM
}

#ifndef MK_MULTI
#define MK_MULTI 0
#endif
extern "C" void kernel_launch(void* const* d_in, const int* in_sizes, int n_in, void* d_out, int out_size, void* d_ws, size_t ws_size, hipStream_t stream) {
    static int grid = 0;
    if (grid == 0) {
        if (n_in != 31 || out_size != M_ * D_ || ws_size < WS_END) { fprintf(stderr, "kernel_launch: unexpected shapes n_in %d out %d ws %zu\n", n_in, out_size, ws_size); grid = -1; return; }
        int dev = 0, cus = 0, per_cu = 0;
        hipGetDevice(&dev); hipDeviceGetAttribute(&cus, hipDeviceAttributeMultiprocessorCount, dev);
        hipFuncSetAttribute((const void*)fwd_megakernel, hipFuncAttributeMaxDynamicSharedMemorySize, LDS_BYTES);
        hipOccupancyMaxActiveBlocksPerMultiprocessor(&per_cu, (const void*)fwd_megakernel, 512, LDS_BYTES);
        if (per_cu < 1) { fprintf(stderr, "kernel_launch: occupancy query says %d blocks per CU\n", per_cu); per_cu = 1; }
        (void)hipGetLastError();
        grid = cus * 1;
    }
    if (grid < 0) return;
    Args a{};
    for (int i = 0; i < 31; ++i) a.in[i] = (const float*)d_in[i];
    a.out = (float*)d_out; a.ws = (unsigned char*)d_ws;
    (void)hipMemsetAsync((unsigned char*)d_ws + WS_BAR, 0, 16384, stream);
#if MK_MULTI
    for (int ph = 0; ph < NPHASE; ++ph) { a.ph_lo = ph; a.ph_hi = ph + 1; hipLaunchKernelGGL(fwd_megakernel, dim3(grid), dim3(512), LDS_BYTES, stream, a); }
#else
    a.ph_lo = 0; a.ph_hi = NPHASE;
    void* args[] = {&a};
    hipError_t e = hipLaunchCooperativeKernel((const void*)fwd_megakernel, dim3(grid), dim3(512), args, LDS_BYTES, stream);
    if (e != hipSuccess) fprintf(stderr, "cooperative launch failed: %s (grid %d)\n", hipGetErrorString(e), grid);
#endif
}
```
